# Optimizing an MI355X kernel written in HIP

```python
import math
import jax, jax.numpy as jnp
from jax import lax
import numpy as np

D_MODEL = 1024
BATCH = 4
SEQ = 4096
DEPTH = 2

CTX_LEN = 256
GRID_W = 64
Q_BLOCK = 128
ROPE_THETA = 10000.0
EPS = 1e-6

MLA_HEADS = 4
MLA_Q_RANK = 384
MLA_KV_RANK = 256
MLA_NOPE = 64
MLA_ROPE = 32
MLA_V = 64
NA_HEADS = 4
NA_DIM = 64
NA_ROWS = 8
NA_COLS = 16
DIFF_HEADS = 4
DIFF_QK = 32
DIFF_V = 64
GQA_HEADS = 4
GQA_KV_HEADS = 2
GQA_DIM = 64
N_BRANCH = 4
BRANCH_W = 256
D_FF = -(-8 * D_MODEL // (3 * 256)) * 256
DEEPNORM_ALPHA = (2 * DEPTH) ** 0.25
DEEPNORM_BETA = (8 * DEPTH) ** -0.25

IN_SIZES = (
    MLA_Q_RANK, MLA_KV_RANK, MLA_ROPE,
    NA_HEADS * NA_DIM, NA_HEADS * NA_DIM, NA_HEADS * NA_DIM,
    DIFF_HEADS * 2 * DIFF_QK, DIFF_HEADS * 2 * DIFF_QK, DIFF_HEADS * DIFF_V,
    GQA_HEADS * GQA_DIM, GQA_KV_HEADS * GQA_DIM, GQA_KV_HEADS * GQA_DIM,
    N_BRANCH * D_MODEL,
)
D_IN = sum(IN_SIZES)

kernel_name = 'hybrid_parallel_mixer_dit_block'


def layer_norm(x, g, b):
    xf = x.astype(jnp.float32)
    mu = jnp.mean(xf, axis=-1, keepdims=True)
    var = jnp.mean(jnp.square(xf - mu), axis=-1, keepdims=True)
    return ((xf - mu) * lax.rsqrt(var + EPS) * g + b).astype(x.dtype)


def rms_norm(x, g):
    xf = x.astype(jnp.float32)
    y = xf * lax.rsqrt(jnp.mean(jnp.square(xf), axis=-1, keepdims=True) + EPS)
    return (y * g).astype(x.dtype)


def rope_tables(S, rot_dim, dtype):
    t = jnp.arange(S)
    pos = jnp.stack([t // GRID_W, t % GRID_W], axis=-1).astype(jnp.float32)
    n_f = rot_dim // 4
    inv = ROPE_THETA ** (-jnp.arange(n_f, dtype=jnp.float32) / n_f)
    ang = pos[:, :, None] * inv
    return jnp.cos(ang).astype(dtype), jnp.sin(ang).astype(dtype)


def apply_rope(x, tab):
    cos, sin = tab
    shp = x.shape
    n_f = shp[-1] // 4
    xr = x.reshape(shp[:-1] + (2, 2, n_f))
    x1, x2 = xr[..., 0, :], xr[..., 1, :]
    bshape = (1, shp[1]) + (1,) * (x.ndim - 3) + (2, n_f)
    c, s = cos.reshape(bshape), sin.reshape(bshape)
    return jnp.stack([x1 * c - x2 * s, x1 * s + x2 * c], axis=-2).reshape(shp)


def attn_probs(q, k, scale):
    B, Q, H, d = q.shape
    Hk = k.shape[2]
    qg = q.reshape(B, Q, Hk, H // Hk, d)
    s = jnp.einsum('bqkgd,btkd->bkgqt', qg, k).astype(jnp.float32) * scale
    return jax.nn.softmax(s, axis=-1)


def attn_apply(p, v):
    o = jnp.einsum('bkgqt,btkd->bqkgd', p.astype(v.dtype), v)
    B, Q, Hk, G, dv = o.shape
    return o.reshape(B, Q, Hk * G, dv)


def dense_attention(q, k, v, scale):
    return attn_apply(attn_probs(q, k, scale), v)


def diff_attention(q, k, v, lam, g_sub, lam_init):
    scale = DIFF_QK ** -0.5
    p1 = attn_probs(q[:, :, :, 0], k[:, :, :, 0], scale)
    p2 = attn_probs(q[:, :, :, 1], k[:, :, :, 1], scale)
    p = p1 - lam[:, None, None, None] * p2
    return rms_norm(attn_apply(p, v), g_sub) * (1.0 - lam_init)


def sweep_query_blocks(fn, q):
    B, S = q.shape[:2]
    nb = S // Q_BLOCK
    qb = jnp.moveaxis(q.reshape((B, nb, Q_BLOCK) + q.shape[2:]), 1, 0)
    o = lax.map(fn, qb)
    return jnp.moveaxis(o, 0, 1).reshape((B, S) + o.shape[3:])


def neighbourhood_attention(q, k, v, k_ctx, v_ctx, rpb):
    B, S, H, d = q.shape
    rows = S // GRID_W
    kh, kw = min(NA_ROWS, rows), NA_COLS
    scale = d ** -0.5
    col = np.arange(GRID_W)
    cs = np.clip(col - kw // 2, 0, GRID_W - kw)
    col_idx = cs[:, None] + np.arange(kw)[None, :]
    col_off = col_idx - col[:, None] + (NA_COLS - 1)
    kg = k.reshape(B, rows, GRID_W, H, d)
    vg = v.reshape(B, rows, GRID_W, H, d)
    qr = jnp.moveaxis(q.reshape(B, rows, GRID_W, H, d), 1, 0)

    def row_block(args):
        r, q_row = args
        rs = jnp.clip(r - kh // 2, 0, rows - kh)
        kb = lax.dynamic_slice_in_dim(kg, rs, kh, axis=1)[:, :, col_idx]
        vb = lax.dynamic_slice_in_dim(vg, rs, kh, axis=1)[:, :, col_idx]
        row_off = rs + jnp.arange(kh) - r + (NA_ROWS - 1)
        bias = jnp.transpose(rpb[:, row_off][:, :, col_off], (0, 2, 1, 3))
        s_loc = jnp.einsum('bwhd,biwjhd->bhwij', q_row, kb).astype(jnp.float32) * scale + bias[None].astype(jnp.float32)
        s_ctx = jnp.einsum('bwhd,bchd->bhwc', q_row, k_ctx).astype(jnp.float32) * scale
        s = jnp.concatenate([s_loc.reshape(B, H, GRID_W, kh * kw), s_ctx], axis=-1)
        p = jax.nn.softmax(s, axis=-1).astype(v.dtype)
        p_loc = p[..., :kh * kw].reshape(B, H, GRID_W, kh, kw)
        p_ctx = p[..., kh * kw:]
        return jnp.einsum('bhwij,biwjhd->bwhd', p_loc, vb) + jnp.einsum('bhwc,bchd->bwhd', p_ctx, v_ctx)

    o = lax.map(row_block, (jnp.arange(rows), qr))
    return jnp.moveaxis(o, 0, 1).reshape(B, S, H, d)


def mixer_inputs(h, w_in, g_q_a, w_q_up, g_kv_a, w_kv_up, g_qn, g_kn, tabs):
    B, T, _ = h.shape
    split_at = [int(i) for i in np.cumsum(IN_SIZES)[:-1]]
    (cq, ckv, kpe, q_na, k_na, v_na, q_df, k_df, v_df, q_gq, k_gq, v_gq, gates) = jnp.split(h @ w_in, split_at, axis=-1)
    qa = (rms_norm(cq, g_q_a) @ w_q_up).reshape(B, T, MLA_HEADS, MLA_NOPE + MLA_ROPE)
    kva = (rms_norm(ckv, g_kv_a) @ w_kv_up).reshape(B, T, MLA_HEADS, MLA_NOPE + MLA_V)
    q_nope, q_pe = qa[..., :MLA_NOPE], qa[..., MLA_NOPE:]
    k_nope, va = kva[..., :MLA_NOPE], kva[..., MLA_NOPE:]
    kpe = kpe.reshape(B, T, 1, MLA_ROPE)
    q_df = q_df.reshape(B, T, DIFF_HEADS, 2, DIFF_QK)
    k_df = k_df.reshape(B, T, DIFF_HEADS, 2, DIFF_QK)
    q_gq = rms_norm(q_gq.reshape(B, T, GQA_HEADS, GQA_DIM), g_qn)
    k_gq = rms_norm(k_gq.reshape(B, T, GQA_KV_HEADS, GQA_DIM), g_kn)
    if tabs is not None:
        q_pe = apply_rope(q_pe, tabs[MLA_ROPE])
        kpe = apply_rope(kpe, tabs[MLA_ROPE])
        q_df = apply_rope(q_df, tabs[DIFF_QK])
        k_df = apply_rope(k_df, tabs[DIFF_QK])
        q_gq = apply_rope(q_gq, tabs[GQA_DIM])
        k_gq = apply_rope(k_gq, tabs[GQA_DIM])
    qa = jnp.concatenate([q_nope, q_pe], axis=-1)
    ka = jnp.concatenate([k_nope, jnp.broadcast_to(kpe, (B, T, MLA_HEADS, MLA_ROPE))], axis=-1)
    return (qa, ka, va,
            q_na.reshape(B, T, NA_HEADS, NA_DIM), k_na.reshape(B, T, NA_HEADS, NA_DIM), v_na.reshape(B, T, NA_HEADS, NA_DIM),
            q_df, k_df, v_df.reshape(B, T, DIFF_HEADS, DIFF_V),
            q_gq, k_gq, v_gq.reshape(B, T, GQA_KV_HEADS, GQA_DIM),
            gates)


def merge_branches(gates, ys, w_branch, w_out):
    B, T, _ = gates.shape
    g = jax.nn.sigmoid(gates.reshape(B, T, N_BRANCH, D_MODEL))
    acc = g[:, :, 0] * (ys[0].reshape(B, T, BRANCH_W) @ w_branch[0])
    for i in range(1, N_BRANCH):
        acc = acc + g[:, :, i] * (ys[i].reshape(B, T, BRANCH_W) @ w_branch[i])
    return acc @ w_out


def token_mixers(hl, hc, tabs, w_in, g_q_a, w_q_up, g_kv_a, w_kv_up, rpb, lam_q1, lam_k1, lam_q2, lam_k2,
                 g_sub, g_qn, g_kn, w_branch, w_out, lam_init, need_ctx):
    proj = (w_in, g_q_a, w_q_up, g_kv_a, w_kv_up, g_qn, g_kn)
    (qa, ka, va, qb, kb, vb, qc, kc, vc, qd, kd, vd, gl) = mixer_inputs(hl, *proj, tabs)
    (xqa, xka, xva, xqb, xkb, xvb, xqc, xkc, xvc, xqd, xkd, xvd, gx) = mixer_inputs(hc, *proj, None)
    lam = (jnp.exp(jnp.sum(lam_q1 * lam_k1, axis=-1).astype(jnp.float32))
           - jnp.exp(jnp.sum(lam_q2 * lam_k2, axis=-1).astype(jnp.float32)) + lam_init)
    cat = lambda a, b: jnp.concatenate([a, b], axis=1)
    ka_all, va_all = cat(ka, xka), cat(va, xva)
    kc_all, vc_all = cat(kc, xkc), cat(vc, xvc)
    kd_all, vd_all = cat(kd, xkd), cat(vd, xvd)
    mla_scale = (MLA_NOPE + MLA_ROPE) ** -0.5
    ya = sweep_query_blocks(lambda q: dense_attention(q, ka_all, va_all, mla_scale), qa)
    yb = neighbourhood_attention(qb, kb, vb, xkb, xvb, rpb)
    yc = sweep_query_blocks(lambda q: diff_attention(q, kc_all, vc_all, lam, g_sub, lam_init), qc)
    yd = sweep_query_blocks(lambda q: dense_attention(q, kd_all, vd_all, GQA_DIM ** -0.5), qd)
    out_l = merge_branches(gl, (ya, yb, yc, yd), w_branch, w_out)
    if not need_ctx:
        return out_l, None
    ya_c = dense_attention(xqa, xka, xva, mla_scale)
    yb_c = dense_attention(xqb, xkb, xvb, NA_DIM ** -0.5)
    yc_c = diff_attention(xqc, xkc, xvc, lam, g_sub, lam_init)
    yd_c = dense_attention(xqd, xkd, xvd, GQA_DIM ** -0.5)
    out_c = merge_branches(gx, (ya_c, yb_c, yc_c, yd_c), w_branch, w_out)
    return out_l, out_c


def swiglu(h, w_gate_up, w_down):
    g, u = jnp.split(h @ w_gate_up, 2, axis=-1)
    return (jax.nn.silu(g) * u) @ w_down


def setup_inputs(seed: int = 0) -> dict:
    key = jax.random.key(seed)
    ks = jax.random.split(key, 27)
    f32 = jnp.float32
    nrm = lambda k, shape, s: jax.random.normal(k, shape, f32) * s
    gain = lambda k, shape: 1.0 + 0.01 * jax.random.normal(k, shape, f32)
    L = DEPTH
    return {
        'x': nrm(ks[0], (BATCH, SEQ, D_MODEL), 1.0),
        'c': nrm(ks[1], (BATCH, D_MODEL), 1.0),
        'ctx': nrm(ks[2], (BATCH, CTX_LEN, D_MODEL), 1.0),
        'c_ctx': nrm(ks[3], (D_MODEL,), 1.0),
        'w_ada': nrm(ks[4], (L, D_MODEL, 6 * D_MODEL), 0.5 * D_MODEL ** -0.5),
        'b_ada': nrm(ks[5], (L, 6 * D_MODEL), 0.01),
        'w_in': nrm(ks[6], (L, D_MODEL, D_IN), D_MODEL ** -0.5),
        'g_q_a': gain(ks[7], (L, MLA_Q_RANK)),
        'w_q_up': nrm(ks[8], (L, MLA_Q_RANK, MLA_HEADS * (MLA_NOPE + MLA_ROPE)), MLA_Q_RANK ** -0.5),
        'g_kv_a': gain(ks[9], (L, MLA_KV_RANK)),
        'w_kv_up': nrm(ks[10], (L, MLA_KV_RANK, MLA_HEADS * (MLA_NOPE + MLA_V)), MLA_KV_RANK ** -0.5),
        'rpb': nrm(ks[11], (L, NA_HEADS, 2 * NA_ROWS - 1, 2 * NA_COLS - 1), 0.1),
        'lam_q1': nrm(ks[12], (L, DIFF_HEADS, DIFF_QK), 0.1),
        'lam_k1': nrm(ks[13], (L, DIFF_HEADS, DIFF_QK), 0.1),
        'lam_q2': nrm(ks[14], (L, DIFF_HEADS, DIFF_QK), 0.1),
        'lam_k2': nrm(ks[15], (L, DIFF_HEADS, DIFF_QK), 0.1),
        'g_sub': gain(ks[16], (L, DIFF_V)),
        'g_qn': gain(ks[17], (L, GQA_DIM)),
        'g_kn': gain(ks[18], (L, GQA_DIM)),
        'w_branch': nrm(ks[19], (L, N_BRANCH, BRANCH_W, D_MODEL), BRANCH_W ** -0.5),
        'w_out': nrm(ks[20], (L, D_MODEL, D_MODEL), DEEPNORM_BETA * D_MODEL ** -0.5),
        'ln1_g': gain(ks[21], (L, D_MODEL)),
        'ln1_b': nrm(ks[22], (L, D_MODEL), 0.01),
        'w_gate_up': nrm(ks[23], (L, D_MODEL, 2 * D_FF), D_MODEL ** -0.5),
        'w_down': nrm(ks[24], (L, D_FF, D_MODEL), DEEPNORM_BETA * D_FF ** -0.5),
        'ln2_g': gain(ks[25], (L, D_MODEL)),
        'ln2_b': nrm(ks[26], (L, D_MODEL), 0.01),
    }


def reference(x, c, ctx, c_ctx, w_ada, b_ada, w_in, g_q_a, w_q_up, g_kv_a, w_kv_up, rpb,
              lam_q1, lam_k1, lam_q2, lam_k2, g_sub, g_qn, g_kn, w_branch, w_out,
              ln1_g, ln1_b, w_gate_up, w_down, ln2_g, ln2_b):
    S = x.shape[1]
    tabs = {d: rope_tables(S, d, x.dtype) for d in (MLA_ROPE, DIFF_QK, GQA_DIM)}
    s_lat = jax.nn.silu(c)
    s_ctx = jax.nn.silu(c_ctx)
    xl, xc = x, ctx
    for l in range(DEPTH):
        need_ctx = l < DEPTH - 1
        lam_init = 0.8 - 0.6 * math.exp(-0.3 * l)
        mod_l = (s_lat @ w_ada[l] + b_ada[l])[:, None, :]
        mod_c = (s_ctx @ w_ada[l] + b_ada[l])[None, None, :]
        sh1, sc1, g1, sh2, sc2, g2 = jnp.split(mod_l, 6, axis=-1)
        xsh1, xsc1, xg1, xsh2, xsc2, xg2 = jnp.split(mod_c, 6, axis=-1)
        hl = xl * (1.0 + sc1) + sh1
        hc = xc * (1.0 + xsc1) + xsh1
        out_l, out_c = token_mixers(hl, hc, tabs, w_in[l], g_q_a[l], w_q_up[l], g_kv_a[l], w_kv_up[l], rpb[l],
                                    lam_q1[l], lam_k1[l], lam_q2[l], lam_k2[l], g_sub[l], g_qn[l], g_kn[l],
                                    w_branch[l], w_out[l], lam_init, need_ctx)
        xl = layer_norm(DEEPNORM_ALPHA * xl + g1 * out_l, ln1_g[l], ln1_b[l])
        hl = xl * (1.0 + sc2) + sh2
        xl = layer_norm(DEEPNORM_ALPHA * xl + g2 * swiglu(hl, w_gate_up[l], w_down[l]), ln2_g[l], ln2_b[l])
        if need_ctx:
            xc = layer_norm(DEEPNORM_ALPHA * xc + xg1 * out_c, ln1_g[l], ln1_b[l])
            hc = xc * (1.0 + xsc2) + xsh2
            xc = layer_norm(DEEPNORM_ALPHA * xc + xg2 * swiglu(hc, w_gate_up[l], w_down[l]), ln2_g[l], ln2_b[l])
    return xl
```

```cpp
#include <hip/hip_runtime.h>
#include <hip/hip_cooperative_groups.h>
#include <cstdio>
namespace cg = cooperative_groups;

#ifndef COOP
#define COOP 1
#endif
#ifndef NAIVE_ATTN
#define NAIVE_ATTN 0
#endif

#define DI __device__ __forceinline__
typedef unsigned short bf16_t;
using bf16x8 = __attribute__((ext_vector_type(8))) short;
using f32x16 = __attribute__((ext_vector_type(16))) float;
#define MFMA32(a, b, c) __builtin_amdgcn_mfma_f32_32x32x16_bf16((a), (b), (c), 0, 0, 0)

constexpr int D = 1024, NB = 4, SEQ = 4096, CTX = 256, TT = 4352, MROWS = 17408;
constexpr int DIN = 6816, NPROJ = 2720, DFF = 2816, RW = 672;
constexpr float EPS = 1e-6f;
constexpr float ALPHA = 1.4142135623730951f;
constexpr int NTHREADS = 256;

constexpr size_t OFF_MOD = 0;
constexpr size_t OFF_T32 = OFF_MOD + 245760;
constexpr size_t OFF_T64 = OFF_T32 + 4096;
constexpr size_t OFF_LAM = OFF_T64 + 8192;
constexpr size_t OFF_XC  = OFF_LAM + 256;
constexpr size_t OFF_WB  = OFF_XC + 4194304;
constexpr size_t W_IN = 0, W_QUP = 6979584, W_KVUP = 7127040, W_BR = 7258112, W_OUT = 8306688, W_GU = 9355264, W_DN = 15122432, W_END = 18006016;
constexpr size_t OFF_H   = OFF_WB + W_END * 2;
constexpr size_t OFF_S0  = OFF_H + 35651584;
constexpr size_t OFF_S1  = OFF_S0 + 35651584;
constexpr size_t OFF_X2  = OFF_S1 + 35651584;
constexpr size_t OFF_BAR = OFF_X2 + 106954752;
constexpr int XCD_BAR_WORDS_C = 3456;
constexpr size_t E64 = 4456448, E96 = 6684672, E2H = 2228224;
constexpr size_t Q_A = 0, K_A = E96, V_A = 2 * E96, Q_B = V_A + E64, K_B = Q_B + E64, V_B = K_B + E64,
                 Q_C = V_B + E64, K_C = Q_C + E64, V_C = K_C + E64, Q_D = V_C + E64, K_D = Q_D + E64, V_D = K_D + E2H;

struct Params {
  const float *x, *c, *ctx, *c_ctx, *w_ada, *b_ada, *w_in, *g_q_a, *w_q_up, *g_kv_a, *w_kv_up, *rpb,
      *lam_q1, *lam_k1, *lam_q2, *lam_k2, *g_sub, *g_qn, *g_kn, *w_branch, *w_out, *ln1_g, *ln1_b,
      *w_gate_up, *w_down, *ln2_g, *ln2_b;
  float* out;
  char* ws;
};

DI float bf2f(bf16_t b) { return __uint_as_float(((unsigned)b) << 16); }
DI bf16_t f2bf(float x) { return __builtin_bit_cast(unsigned short, (__bf16)x); }
typedef __bf16 bf16x2_t __attribute__((ext_vector_type(2)));
typedef float f32x2_t __attribute__((ext_vector_type(2)));
DI unsigned pack2(float a, float b) { f32x2_t v = {a, b}; return __builtin_bit_cast(unsigned, __builtin_convertvector(v, bf16x2_t)); }
DI float xhalf_max(float x) { auto r = __builtin_amdgcn_permlane32_swap(__float_as_uint(x), __float_as_uint(x), false, false); return fmaxf(__uint_as_float(r[0]), __uint_as_float(r[1])); }
DI float xhalf_sum(float x) { auto r = __builtin_amdgcn_permlane32_swap(__float_as_uint(x), __float_as_uint(x), false, false); return __uint_as_float(r[0]) + __uint_as_float(r[1]); }
template <int CTRL> DI float dpp_mov(float x) { return __int_as_float(__builtin_amdgcn_update_dpp(0, __float_as_int(x), CTRL, 0xF, 0xF, true)); }
DI float xhalf_sum(float x);
DI float wave_sum(float v) {
  v += dpp_mov<0xB1>(v);
  v += dpp_mov<0x4E>(v);
  v += dpp_mov<0x141>(v);
  v += dpp_mov<0x140>(v);
  v += __shfl_xor(v, 16);
  return xhalf_sum(v);
}
DI int opaque(int x) { asm volatile("" : "+v"(x)); return x; }
DI int crow(int reg, int h) { return (reg & 3) + 8 * (reg >> 2) + 4 * h; }
DI float lam_init_of(int l) { return l == 0 ? 0.2f : 0.35550907f; }

DI float* ws_f(const Params& p, size_t off) { return (float*)(p.ws + off); }
DI bf16_t* ws_b(const Params& p, size_t off) { return (bf16_t*)(p.ws + off); }
DI bf16_t* qkv(const Params& p, size_t eoff) { return (bf16_t*)(p.ws + OFF_X2) + eoff; }
DI bf16_t* wb(const Params& p, size_t eoff) { return (bf16_t*)(p.ws + OFF_WB) + eoff; }

DI const float* xsrc_row(const Params& p, int l, int b, int t) {
  if (l == 0) return t < SEQ ? p.x + ((size_t)b * SEQ + t) * D : p.ctx + ((size_t)b * CTX + (t - SEQ)) * D;
  return t < SEQ ? p.out + ((size_t)b * SEQ + t) * D : ws_f(p, OFF_XC) + ((size_t)b * CTX + (t - SEQ)) * D;
}
DI float* xdst_row(const Params& p, int b, int t) {
  return t < SEQ ? p.out + ((size_t)b * SEQ + t) * D : ws_f(p, OFF_XC) + ((size_t)b * CTX + (t - SEQ)) * D;
}

DI void conv_unit(const float* __restrict__ src, int ld_src, int k0, int n0, bf16_t* __restrict__ dst, int ld_dst, int ndst0, float* tile) {
  const int tid = threadIdx.x;
  {
    const int n = tid & 31, kb = tid >> 5;
    float v[16];
#pragma unroll
    for (int i = 0; i < 16; ++i) v[i] = src[(size_t)(k0 + kb + 8 * i) * ld_src + n0 + n];
#pragma unroll
    for (int i = 0; i < 16; ++i) tile[(kb + 8 * i) * 33 + n] = v[i];
  }
  __syncthreads();
  {
    const int nn = tid >> 3, kc = tid & 7;
    float v[16];
#pragma unroll
    for (int j = 0; j < 16; ++j) v[j] = tile[(kc * 16 + j) * 33 + nn];
    uint4 o0, o1;
    o0.x = pack2(v[0], v[1]); o0.y = pack2(v[2], v[3]); o0.z = pack2(v[4], v[5]); o0.w = pack2(v[6], v[7]);
    o1.x = pack2(v[8], v[9]); o1.y = pack2(v[10], v[11]); o1.z = pack2(v[12], v[13]); o1.w = pack2(v[14], v[15]);
    bf16_t* d = dst + (size_t)(ndst0 + nn) * ld_dst + k0 + kc * 16;
    *(uint4*)d = o0; *(uint4*)(d + 8) = o1;
  }
  __syncthreads();
}

DI void convert_weights(const Params& p, int l, int bid, int nb, char* smem) {
  float* tile = (float*)smem;
  int* s_u = (int*)(smem + 128 * 33 * 4);
  unsigned* ctr = (unsigned*)(p.ws + OFF_BAR) + XCD_BAR_WORDS_C + 64 * l;
  for (;;) {
    if (threadIdx.x == 0) *s_u = (int)__hip_atomic_fetch_add(ctr, 1u, __ATOMIC_RELAXED, __HIP_MEMORY_SCOPE_AGENT);
    __syncthreads();
    const int u = *s_u;
    __syncthreads();
    if (u >= 4396) break;
    int v = u;
    if (v < 1704) { int kt = v / 213, nt = v % 213; conv_unit(p.w_in + (size_t)l * 1024 * DIN, DIN, kt * 128, nt * 32, wb(p, W_IN), 1024, nt * 32, tile); continue; }
    v -= 1704;
    if (v < 36) { int kt = v / 12, nt = v % 12; conv_unit(p.w_q_up + (size_t)l * 384 * 384, 384, kt * 128, nt * 32, wb(p, W_QUP), 384, nt * 32, tile); continue; }
    v -= 36;
    if (v < 32) { int kt = v / 16, nt = v % 16; conv_unit(p.w_kv_up + (size_t)l * 256 * 512, 512, kt * 128, nt * 32, wb(p, W_KVUP), 256, nt * 32, tile); continue; }
    v -= 32;
    if (v < 256) { int i = v / 64, r = v % 64, kt = r / 32, nt = r % 32;
      conv_unit(p.w_branch + (size_t)(l * 4 + i) * 256 * 1024, 1024, kt * 128, nt * 32, wb(p, W_BR) + (size_t)i * 1024 * 256, 256, nt * 32, tile); continue; }
    v -= 256;
    if (v < 256) { int kt = v / 32, nt = v % 32; conv_unit(p.w_out + (size_t)l * 1024 * 1024, 1024, kt * 128, nt * 32, wb(p, W_OUT), 1024, nt * 32, tile); continue; }
    v -= 256;
    if (v < 1408) { int kt = v / 176, nt = v % 176; int nd = (nt < 88) ? nt * 64 : (nt - 88) * 64 + 32;
      conv_unit(p.w_gate_up + (size_t)l * 1024 * 5632, 5632, kt * 128, nt * 32, wb(p, W_GU), 1024, nd, tile); continue; }
    v -= 1408;
    { int kt = v / 32, nt = v % 32; conv_unit(p.w_down + (size_t)l * DFF * 1024, 1024, kt * 128, nt * 32, wb(p, W_DN), DFF, nt * 32, tile); }
  }
}

DI void phase_prologue(const Params& p, int bid, int nb, char* smem) {
  const int tid = threadIdx.x;
  float* sc = (float*)smem;
  float* red = sc + 5120;
  if (bid < 384) {
    for (int i = tid; i < 5120; i += NTHREADS) {
      const int j = i >> 10, k = i & 1023;
      const float v = (j < 4) ? p.c[j * 1024 + k] : p.c_ctx[k];
      sc[i] = v / (1.f + expf(-v));
    }
    __syncthreads();
    float* mod = ws_f(p, OFF_MOD);
    for (int u = bid; u < 384; u += nb) {
      const int l = u / 192, grp = u % 192, nn = tid & 31, kq = tid >> 5, n = grp * 32 + nn;
      const float* w = p.w_ada + ((size_t)l * 1024 + kq * 128) * 6144 + n;
      float s0 = 0, s1 = 0, s2 = 0, s3 = 0, s4 = 0;
#pragma unroll 16
      for (int k = 0; k < 128; ++k) {
        const float wv = w[(size_t)k * 6144];
        const int kk = kq * 128 + k;
        s0 += sc[kk] * wv; s1 += sc[1024 + kk] * wv; s2 += sc[2048 + kk] * wv; s3 += sc[3072 + kk] * wv; s4 += sc[4096 + kk] * wv;
      }
      red[(kq * 5 + 0) * 32 + nn] = s0; red[(kq * 5 + 1) * 32 + nn] = s1; red[(kq * 5 + 2) * 32 + nn] = s2;
      red[(kq * 5 + 3) * 32 + nn] = s3; red[(kq * 5 + 4) * 32 + nn] = s4;
      __syncthreads();
      if (tid < 160) {
        const int j = tid >> 5, c = tid & 31;
        float acc = p.b_ada[l * 6144 + grp * 32 + c];
#pragma unroll
        for (int q = 0; q < 8; ++q) acc += red[(q * 5 + j) * 32 + c];
        mod[(size_t)(l * 5 + j) * 6144 + grp * 32 + c] = acc;
      }
      __syncthreads();
    }
  }
  if (bid == nb - 1) {
    float2* t32 = (float2*)(p.ws + OFF_T32);
    float2* t64 = (float2*)(p.ws + OFF_T64);
    for (int i = tid; i < 512; i += NTHREADS) { const int pos = i >> 3, f = i & 7; const float inv = powf(10000.f, -(float)f / 8.f); const float a = (float)pos * inv; t32[i] = make_float2(cosf(a), sinf(a)); }
    for (int i = tid; i < 1024; i += NTHREADS) { const int pos = i >> 4, f = i & 15; const float inv = powf(10000.f, -(float)f / 16.f); const float a = (float)pos * inv; t64[i] = make_float2(cosf(a), sinf(a)); }
    if (tid < 8) {
      const int l = tid >> 2, h = tid & 3;
      float a = 0, b2 = 0;
      for (int e = 0; e < 32; ++e) { a += p.lam_q1[(l * 4 + h) * 32 + e] * p.lam_k1[(l * 4 + h) * 32 + e]; b2 += p.lam_q2[(l * 4 + h) * 32 + e] * p.lam_k2[(l * 4 + h) * 32 + e]; }
      ws_f(p, OFF_LAM)[tid] = expf(a) - expf(b2) + lam_init_of(l);
    }
  }
  __syncthreads();
  convert_weights(p, 0, bid, nb, smem);
}

DI void store_h4(bf16_t* dst, float a, float b, float c, float d) { uint2 o; o.x = pack2(a, b); o.y = pack2(c, d); *(uint2*)dst = o; }

DI void phase_modulate0(const Params& p, int bid, int nb) {
  const int lane = threadIdx.x & 63, wave = threadIdx.x >> 6;
  bf16_t* H = ws_b(p, OFF_H);
  const float* mod = ws_f(p, OFF_MOD);
  for (int row = bid * 4 + wave; row < MROWS; row += nb * 4) {
    const int b = row / TT, t = row % TT;
    const float* src = xsrc_row(p, 0, b, t);
    const float* m = mod + (size_t)(0 * 5 + (t < SEQ ? b : 4)) * 6144;
#pragma unroll
    for (int i = 0; i < 4; ++i) {
      const int c = (i * 64 + lane) * 4;
      const float4 x = *(const float4*)(src + c);
      const float4 sh = *(const float4*)(m + c);
      const float4 s = *(const float4*)(m + 1024 + c);
      store_h4(H + (size_t)row * D + c, x.x * (1.f + s.x) + sh.x, x.y * (1.f + s.y) + sh.y, x.z * (1.f + s.z) + sh.z, x.w * (1.f + s.w) + sh.w);
    }
  }
}

constexpr int LROW = 64;
constexpr int LTILE = 128 * LROW;
#define WAIT_V0() asm volatile("s_waitcnt vmcnt(0)" ::: "memory")
#define GLDS16(gp, lp) __builtin_amdgcn_global_load_lds((const unsigned*)(gp), (unsigned*)(lp), 16, 0, 0)
#define STAGE_A(buf, kt) { _Pragma("unroll") for (int i = 0; i < 4; ++i) GLDS16(ga + (size_t)(32 * i) * lda + (kt) * 64, sA + (buf) * LTILE + (i * 32 + wave * 8) * LROW); }
#define STAGE_B(buf, kt, NI) { _Pragma("unroll") for (int i = 0; i < (NI); ++i) GLDS16(gb + (size_t)(32 * i) * ldb + (kt) * 64, sB + (buf) * LTILE + (i * 32 + wave * 8) * LROW); }
#define CORE_SETUP() \
  const int tid = opaque(threadIdx.x), lane = tid & 63, wave = tid >> 6; \
  const int wm = wave >> 1, wn = wave & 1; \
  const int srow = tid >> 3, skc = (tid & 7) ^ ((srow >> 1) & 7); \
  const bf16_t* ga = A + (size_t)srow * lda + skc * 8; \
  const bf16_t* gb = B + (size_t)srow * ldb + skc * 8; \
  const int l31 = lane & 31, fh = lane >> 5, fsw = (lane >> 1) & 7; \
  const int c0 = ((0 + fh) ^ fsw) * 8, c1 = ((2 + fh) ^ fsw) * 8, c2 = ((4 + fh) ^ fsw) * 8, c3 = ((6 + fh) ^ fsw) * 8;

#define LDSA(p) ((unsigned)(size_t)(p))
DI void lds_read16(bf16x8& a00, bf16x8& a01, bf16x8& b00, bf16x8& b01, bf16x8& a10, bf16x8& a11, bf16x8& b10, bf16x8& b11,
                   bf16x8& a20, bf16x8& a21, bf16x8& b20, bf16x8& b21, bf16x8& a30, bf16x8& a31, bf16x8& b30, bf16x8& b31,
                   unsigned pa0, unsigned pa1, unsigned pa2, unsigned pa3, unsigned pb0, unsigned pb1, unsigned pb2, unsigned pb3) {
  asm volatile(
      "ds_read_b128 %0, %16\n\tds_read_b128 %1, %16 offset:4096\n\tds_read_b128 %2, %20\n\tds_read_b128 %3, %20 offset:4096\n\t"
      "ds_read_b128 %4, %17\n\tds_read_b128 %5, %17 offset:4096\n\tds_read_b128 %6, %21\n\tds_read_b128 %7, %21 offset:4096\n\t"
      "ds_read_b128 %8, %18\n\tds_read_b128 %9, %18 offset:4096\n\tds_read_b128 %10, %22\n\tds_read_b128 %11, %22 offset:4096\n\t"
      "ds_read_b128 %12, %19\n\tds_read_b128 %13, %19 offset:4096\n\tds_read_b128 %14, %23\n\tds_read_b128 %15, %23 offset:4096"
      : "=&v"(a00), "=&v"(a01), "=&v"(b00), "=&v"(b01), "=&v"(a10), "=&v"(a11), "=&v"(b10), "=&v"(b11),
        "=&v"(a20), "=&v"(a21), "=&v"(b20), "=&v"(b21), "=&v"(a30), "=&v"(a31), "=&v"(b30), "=&v"(b31)
      : "v"(pa0), "v"(pa1), "v"(pa2), "v"(pa3), "v"(pb0), "v"(pb1), "v"(pb2), "v"(pb3)
      : "memory");
}
#define LGKM_WAIT4(n, x0, x1, x2, x3) asm volatile("s_waitcnt lgkmcnt(" #n ")" : "+v"(x0), "+v"(x1), "+v"(x2), "+v"(x3))
DI void lds_read4(bf16x8& a0, bf16x8& a1, bf16x8& b0, bf16x8& b1, unsigned pa, unsigned pb) {
  asm volatile("ds_read_b128 %0, %4\n\tds_read_b128 %1, %4 offset:4096\n\tds_read_b128 %2, %5\n\tds_read_b128 %3, %5 offset:4096\n\ts_waitcnt lgkmcnt(0)"
               : "=&v"(a0), "=&v"(a1), "=&v"(b0), "=&v"(b1) : "v"(pa), "v"(pb) : "memory");
}
DI void lds_read3(bf16x8& a0, bf16x8& a1, bf16x8& b0, unsigned pa, unsigned pb) {
  asm volatile("ds_read_b128 %0, %3\n\tds_read_b128 %1, %3 offset:4096\n\tds_read_b128 %2, %4\n\ts_waitcnt lgkmcnt(0)"
               : "=&v"(a0), "=&v"(a1), "=&v"(b0) : "v"(pa), "v"(pb) : "memory");
}

DI void gemm_accum(f32x16 (&acc)[2][2], const bf16_t* __restrict__ A, int lda, const bf16_t* __restrict__ B, int ldb, int nk, bf16_t* sA, bf16_t* sB) {
  CORE_SETUP()
  STAGE_A(0, 0) STAGE_B(0, 0, 4)
  WAIT_V0(); __syncthreads();
  const unsigned la = LDSA(sA) + (wm * 64 + l31) * (LROW * 2), lb = LDSA(sB) + (wn * 64 + l31) * (LROW * 2);
#pragma unroll 1
  for (int kt = 0; kt < nk; ++kt) {
    const int cur = kt & 1;
    if (kt + 1 < nk) { STAGE_A(cur ^ 1, kt + 1) STAGE_B(cur ^ 1, kt + 1, 4) }
    const unsigned pa = la + cur * (LTILE * 2), pb = lb + cur * (LTILE * 2);
    bf16x8 a00, a01, b00, b01, a10, a11, b10, b11, a20, a21, b20, b21, a30, a31, b30, b31;
    lds_read16(a00, a01, b00, b01, a10, a11, b10, b11, a20, a21, b20, b21, a30, a31, b30, b31,
               pa + c0 * 2, pa + c1 * 2, pa + c2 * 2, pa + c3 * 2, pb + c0 * 2, pb + c1 * 2, pb + c2 * 2, pb + c3 * 2);
    LGKM_WAIT4(12, a00, a01, b00, b01);
    __builtin_amdgcn_s_setprio(1);
    acc[0][0] = MFMA32(a00, b00, acc[0][0]); acc[0][1] = MFMA32(a00, b01, acc[0][1]); acc[1][0] = MFMA32(a01, b00, acc[1][0]); acc[1][1] = MFMA32(a01, b01, acc[1][1]);
    __builtin_amdgcn_sched_barrier(0);
    LGKM_WAIT4(8, a10, a11, b10, b11);
    acc[0][0] = MFMA32(a10, b10, acc[0][0]); acc[0][1] = MFMA32(a10, b11, acc[0][1]); acc[1][0] = MFMA32(a11, b10, acc[1][0]); acc[1][1] = MFMA32(a11, b11, acc[1][1]);
    __builtin_amdgcn_sched_barrier(0);
    LGKM_WAIT4(4, a20, a21, b20, b21);
    acc[0][0] = MFMA32(a20, b20, acc[0][0]); acc[0][1] = MFMA32(a20, b21, acc[0][1]); acc[1][0] = MFMA32(a21, b20, acc[1][0]); acc[1][1] = MFMA32(a21, b21, acc[1][1]);
    __builtin_amdgcn_sched_barrier(0);
    LGKM_WAIT4(0, a30, a31, b30, b31);
    acc[0][0] = MFMA32(a30, b30, acc[0][0]); acc[0][1] = MFMA32(a30, b31, acc[0][1]); acc[1][0] = MFMA32(a31, b30, acc[1][0]); acc[1][1] = MFMA32(a31, b31, acc[1][1]);
    __builtin_amdgcn_s_setprio(0);
    __builtin_amdgcn_sched_barrier(0);
    WAIT_V0(); __syncthreads();
  }
}
DI void lds_read8(bf16x8& a00, bf16x8& a01, bf16x8& b00, bf16x8& b01, bf16x8& a10, bf16x8& a11, bf16x8& b10, bf16x8& b11,
                  unsigned pa0, unsigned pa1, unsigned pb0, unsigned pb1) {
  asm volatile(
      "ds_read_b128 %0, %8\n\tds_read_b128 %1, %8 offset:4096\n\tds_read_b128 %2, %10\n\tds_read_b128 %3, %10 offset:4096\n\t"
      "ds_read_b128 %4, %9\n\tds_read_b128 %5, %9 offset:4096\n\tds_read_b128 %6, %11\n\tds_read_b128 %7, %11 offset:4096"
      : "=&v"(a00), "=&v"(a01), "=&v"(b00), "=&v"(b01), "=&v"(a10), "=&v"(a11), "=&v"(b10), "=&v"(b11)
      : "v"(pa0), "v"(pa1), "v"(pb0), "v"(pb1) : "memory");
}
DI void gemm_accum_lite(f32x16 (&acc)[2][2], const bf16_t* __restrict__ A, int lda, const bf16_t* __restrict__ B, int ldb, int nk, bf16_t* sA, bf16_t* sB) {
  CORE_SETUP()
  STAGE_A(0, 0) STAGE_B(0, 0, 4)
  WAIT_V0(); __syncthreads();
  const unsigned la = LDSA(sA) + (wm * 64 + l31) * (LROW * 2), lb = LDSA(sB) + (wn * 64 + l31) * (LROW * 2);
#pragma unroll 1
  for (int kt = 0; kt < nk; ++kt) {
    const int cur = kt & 1;
    if (kt + 1 < nk) { STAGE_A(cur ^ 1, kt + 1) STAGE_B(cur ^ 1, kt + 1, 4) }
    const unsigned pa = la + cur * (LTILE * 2), pb = lb + cur * (LTILE * 2);
#pragma unroll
    for (int g = 0; g < 2; ++g) {
      const int ca = g ? c2 : c0, cb = g ? c3 : c1;
      bf16x8 a00, a01, b00, b01, a10, a11, b10, b11;
      lds_read8(a00, a01, b00, b01, a10, a11, b10, b11, pa + ca * 2, pa + cb * 2, pb + ca * 2, pb + cb * 2);
      LGKM_WAIT4(4, a00, a01, b00, b01);
      __builtin_amdgcn_s_setprio(1);
      acc[0][0] = MFMA32(a00, b00, acc[0][0]); acc[0][1] = MFMA32(a00, b01, acc[0][1]); acc[1][0] = MFMA32(a01, b00, acc[1][0]); acc[1][1] = MFMA32(a01, b01, acc[1][1]);
      __builtin_amdgcn_sched_barrier(0);
      LGKM_WAIT4(0, a10, a11, b10, b11);
      acc[0][0] = MFMA32(a10, b10, acc[0][0]); acc[0][1] = MFMA32(a10, b11, acc[0][1]); acc[1][0] = MFMA32(a11, b10, acc[1][0]); acc[1][1] = MFMA32(a11, b11, acc[1][1]);
      __builtin_amdgcn_s_setprio(0);
      __builtin_amdgcn_sched_barrier(0);
    }
    WAIT_V0(); __syncthreads();
  }
}
DI void zero_acc(f32x16 (&acc)[2][2]) {
#pragma unroll
  for (int a = 0; a < 2; ++a)
#pragma unroll
    for (int b = 0; b < 2; ++b)
#pragma unroll
      for (int i = 0; i < 16; ++i) acc[a][b][i] = 0.f;
}

DI void gemm_accum_n64(f32x16 (&acc)[2], const bf16_t* __restrict__ A, int lda, const bf16_t* __restrict__ B, int ldb, int nk, bf16_t* sA, bf16_t* sB) {
  CORE_SETUP()
  STAGE_A(0, 0) STAGE_B(0, 0, 2)
  WAIT_V0(); __syncthreads();
  const unsigned la = LDSA(sA) + (wm * 64 + l31) * (LROW * 2), lb = LDSA(sB) + (wn * 32 + l31) * (LROW * 2);
#pragma unroll 1
  for (int kt = 0; kt < nk; ++kt) {
    const int cur = kt & 1;
    if (kt + 1 < nk) { STAGE_A(cur ^ 1, kt + 1) STAGE_B(cur ^ 1, kt + 1, 2) }
    const unsigned pa = la + cur * (LTILE * 2), pb = lb + cur * (LTILE * 2);
#pragma unroll
    for (int kk = 0; kk < 4; ++kk) {
      const int ck = (kk == 0) ? c0 : (kk == 1) ? c1 : (kk == 2) ? c2 : c3;
      bf16x8 a0, a1, b0;
      lds_read3(a0, a1, b0, pa + ck * 2, pb + ck * 2);
      acc[0] = MFMA32(a0, b0, acc[0]); acc[1] = MFMA32(a1, b0, acc[1]);
      __builtin_amdgcn_sched_barrier(0);
    }
    WAIT_V0(); __syncthreads();
  }
}

constexpr int WA_STG = 128 * 32, WB_STG = 256 * 32;
#define WSTAGE_A(s, kt) { _Pragma("unroll") for (int i = 0; i < 2; ++i) GLDS16(ga + (size_t)(64 * i) * lda + (kt) * 32, sA + (s) * WA_STG + (i * 64 + wave * 16) * 32); }
#define WSTAGE_B(s, kt) { _Pragma("unroll") for (int i = 0; i < 4; ++i) GLDS16(gb + (size_t)(64 * i) * ldb + (kt) * 32, sB + (s) * WB_STG + (i * 64 + wave * 16) * 32); }
#define LGKM_WAIT6(n, x0, x1, x2, x3, x4, x5) asm volatile("s_waitcnt lgkmcnt(" #n ")" : "+v"(x0), "+v"(x1), "+v"(x2), "+v"(x3), "+v"(x4), "+v"(x5))
DI void lds_read12(bf16x8& a00, bf16x8& a01, bf16x8& b00, bf16x8& b01, bf16x8& b02, bf16x8& b03,
                   bf16x8& a10, bf16x8& a11, bf16x8& b10, bf16x8& b11, bf16x8& b12, bf16x8& b13,
                   unsigned pa0, unsigned pa1, unsigned pb0, unsigned pb1) {
  asm volatile(
      "ds_read_b128 %0, %12\n\tds_read_b128 %1, %12 offset:2048\n\t"
      "ds_read_b128 %2, %14\n\tds_read_b128 %3, %14 offset:2048\n\tds_read_b128 %4, %14 offset:4096\n\tds_read_b128 %5, %14 offset:6144\n\t"
      "ds_read_b128 %6, %13\n\tds_read_b128 %7, %13 offset:2048\n\t"
      "ds_read_b128 %8, %15\n\tds_read_b128 %9, %15 offset:2048\n\tds_read_b128 %10, %15 offset:4096\n\tds_read_b128 %11, %15 offset:6144"
      : "=&v"(a00), "=&v"(a01), "=&v"(b00), "=&v"(b01), "=&v"(b02), "=&v"(b03),
        "=&v"(a10), "=&v"(a11), "=&v"(b10), "=&v"(b11), "=&v"(b12), "=&v"(b13)
      : "v"(pa0), "v"(pa1), "v"(pb0), "v"(pb1) : "memory");
}
DI void gemm_accum_wide(f32x16 (&acc)[2][4], const bf16_t* __restrict__ A, int lda, const bf16_t* __restrict__ B, int ldb, int nk32, bf16_t* sA, bf16_t* sB) {
  const int tid = opaque(threadIdx.x), lane = tid & 63, wave = tid >> 6;
  const int wm = wave >> 1, wn = wave & 1;
  const int srow = tid >> 2, skc = (tid & 3) ^ ((srow >> 2) & 3);
  const bf16_t* ga = A + (size_t)srow * lda + skc * 8;
  const bf16_t* gb = B + (size_t)srow * ldb + skc * 8;
  const int l31 = lane & 31, fh = lane >> 5, fsw = (lane >> 2) & 3;
  const unsigned c0 = (unsigned)((fh ^ fsw) * 16), c1 = (unsigned)(((2 + fh) ^ fsw) * 16);
  const unsigned la = LDSA(sA) + (wm * 64 + l31) * 64, lb = LDSA(sB) + (wn * 128 + l31) * 64;
  WSTAGE_A(0, 0) WSTAGE_B(0, 0)
  WAIT_V0(); __syncthreads();
#pragma unroll 1
  for (int kt = 0; kt < nk32; ++kt) {
    const int cur = kt & 1;
    if (kt + 1 < nk32) { WSTAGE_A(cur ^ 1, kt + 1) WSTAGE_B(cur ^ 1, kt + 1) }
    const unsigned pa = la + cur * (WA_STG * 2), pb = lb + cur * (WB_STG * 2);
    bf16x8 a00, a01, b00, b01, b02, b03, a10, a11, b10, b11, b12, b13;
    lds_read12(a00, a01, b00, b01, b02, b03, a10, a11, b10, b11, b12, b13, pa + c0, pa + c1, pb + c0, pb + c1);
    LGKM_WAIT6(6, a00, a01, b00, b01, b02, b03);
    __builtin_amdgcn_s_setprio(1);
    acc[0][0] = MFMA32(a00, b00, acc[0][0]); acc[0][1] = MFMA32(a00, b01, acc[0][1]); acc[0][2] = MFMA32(a00, b02, acc[0][2]); acc[0][3] = MFMA32(a00, b03, acc[0][3]);
    acc[1][0] = MFMA32(a01, b00, acc[1][0]); acc[1][1] = MFMA32(a01, b01, acc[1][1]); acc[1][2] = MFMA32(a01, b02, acc[1][2]); acc[1][3] = MFMA32(a01, b03, acc[1][3]);
    __builtin_amdgcn_sched_barrier(0);
    LGKM_WAIT6(0, a10, a11, b10, b11, b12, b13);
    acc[0][0] = MFMA32(a10, b10, acc[0][0]); acc[0][1] = MFMA32(a10, b11, acc[0][1]); acc[0][2] = MFMA32(a10, b12, acc[0][2]); acc[0][3] = MFMA32(a10, b13, acc[0][3]);
    acc[1][0] = MFMA32(a11, b10, acc[1][0]); acc[1][1] = MFMA32(a11, b11, acc[1][1]); acc[1][2] = MFMA32(a11, b12, acc[1][2]); acc[1][3] = MFMA32(a11, b13, acc[1][3]);
    __builtin_amdgcn_s_setprio(0);
    __builtin_amdgcn_sched_barrier(0);
    WAIT_V0(); __syncthreads();
  }
}

DI void decode_tile(int idx, int xcd, int nmt, int NT, int& mt_lin, int& nt) {
  const int MB = nmt >> 3;
  if (idx < 8 * NT) { nt = idx >> 3; mt_lin = xcd * MB + (idx & 7); }
  else { const int i2 = idx - 8 * NT, gsz = MB - 8; nt = i2 / gsz; mt_lin = xcd * MB + 8 + i2 % gsz; }
}
DI int map_mtile(int mt, bool latent_only) { return latent_only ? (mt >> 5) * 34 + (mt & 31) : mt; }

DI void store_hm(bf16_t* base, int nh, int hd, int b, int t0, int cs, int h, const f32x16& a) {
  const int hh = cs / hd, d = cs % hd;
  bf16_t* dst = base + ((size_t)(b * nh + hh) * TT + t0) * hd + d;
#pragma unroll
  for (int r = 0; r < 16; ++r) dst[(size_t)crow(r, h) * hd] = f2bf(a[r]);
}
DI void store_tr(bf16_t* base, int nh, int b, int t0, int cs, int h, const f32x16& a) {
  const int hh = cs >> 6, d = cs & 63;
  bf16_t* dst = base + ((size_t)(b * nh + hh) * 64 + d) * TT + t0 + 4 * h;
#pragma unroll
  for (int g = 0; g < 4; ++g) { uint2 o; o.x = pack2(a[4 * g], a[4 * g + 1]); o.y = pack2(a[4 * g + 2], a[4 * g + 3]); *(uint2*)(dst + 8 * g) = o; }
}

DI void phase_gemm1(const Params& p, int bid, int nb, char* smem) {
  bf16_t* sA = (bf16_t*)smem; bf16_t* sB = sA + 2 * WA_STG;
  const bf16_t* H = ws_b(p, OFF_H);
  bf16_t* R = ws_b(p, OFF_S1);
  for (int idx = bid >> 3; idx < 17 * 11; idx += nb >> 3) {
    int mt, nt; decode_tile(idx, bid & 7, 136, 11, mt, nt);
    f32x16 acc[2][4];
#pragma unroll
    for (int a = 0; a < 2; ++a)
#pragma unroll
      for (int c = 0; c < 4; ++c)
#pragma unroll
        for (int r = 0; r < 16; ++r) acc[a][c][r] = 0.f;
    gemm_accum_wide(acc, H + (size_t)mt * 128 * D, D, wb(p, W_IN) + (size_t)nt * 256 * 1024, 1024, 32, sA, sB);
    const int t2 = opaque(threadIdx.x), wm = t2 >> 7, wn = (t2 >> 6) & 1, hq = (t2 >> 5) & 1, lq = t2 & 31;
#pragma unroll
    for (int mi = 0; mi < 2; ++mi)
#pragma unroll
      for (int ni = 0; ni < 4; ++ni) {
        const int row0 = mt * 128 + wm * 64 + mi * 32, c0 = nt * 256 + wn * 128 + ni * 32;
        if (c0 >= NPROJ) continue;
        const int b = row0 / TT, t0 = row0 % TT, col = c0 + lq;
        const f32x16& a = acc[mi][ni];
        if (c0 < RW) {
          bf16_t* dst = R + (size_t)row0 * RW + col;
#pragma unroll
          for (int r = 0; r < 16; ++r) dst[(size_t)crow(r, hq) * RW] = f2bf(a[r]);
        } else {
          const int cc = col - RW, seg = (c0 - RW) >> 8, cs = cc & 255;
          if (seg == 0) store_hm(qkv(p, Q_B), 4, 64, b, t0, cs, hq, a);
          else if (seg == 1) store_hm(qkv(p, K_B), 4, 64, b, t0, cs, hq, a);
          else if (seg == 2) store_tr(qkv(p, V_B), 4, b, t0, cs, hq, a);
          else if (seg == 3) store_hm(qkv(p, Q_C), 8, 32, b, t0, cs, hq, a);
          else if (seg == 4) store_hm(qkv(p, K_C), 8, 32, b, t0, cs, hq, a);
          else if (seg == 5) store_tr(qkv(p, V_C), 4, b, t0, cs, hq, a);
          else if (seg == 6) store_hm(qkv(p, Q_D), 4, 64, b, t0, cs, hq, a);
          else { if (cs < 128) store_hm(qkv(p, K_D), 2, 64, b, t0, cs, hq, a); else store_tr(qkv(p, V_D), 2, b, t0, cs - 128, hq, a); }
        }
      }
  }
}

DI void phase_rowwise(const Params& p, int l, int bid, int nb) {
  const int lane = threadIdx.x & 63, wave = threadIdx.x >> 6;
  bf16_t* R = ws_b(p, OFF_S1);
  float gq[6], gkv[4];
#pragma unroll
  for (int i = 0; i < 6; ++i) gq[i] = p.g_q_a[l * 384 + lane + 64 * i];
#pragma unroll
  for (int i = 0; i < 4; ++i) gkv[i] = p.g_kv_a[l * 256 + lane + 64 * i];
  for (int row = bid * 4 + wave; row < MROWS; row += nb * 4) {
    bf16_t* rr = R + (size_t)row * RW;
    bf16_t lcq[6], lckv[4];
#pragma unroll
    for (int i = 0; i < 6; ++i) lcq[i] = rr[lane + 64 * i];
#pragma unroll
    for (int i = 0; i < 4; ++i) lckv[i] = rr[384 + lane + 64 * i];
    {
      float x[6], ss = 0.f;
#pragma unroll
      for (int i = 0; i < 6; ++i) { x[i] = bf2f(lcq[i]); ss += x[i] * x[i]; }
      ss = wave_sum(ss);
      const float sc = rsqrtf(ss * (1.f / 384.f) + EPS);
#pragma unroll
      for (int i = 0; i < 6; ++i) rr[lane + 64 * i] = f2bf(x[i] * sc * gq[i]);
    }
    {
      float x[4], ss = 0.f;
#pragma unroll
      for (int i = 0; i < 4; ++i) { x[i] = bf2f(lckv[i]); ss += x[i] * x[i]; }
      ss = wave_sum(ss);
      const float sc = rsqrtf(ss * (1.f / 256.f) + EPS);
#pragma unroll
      for (int i = 0; i < 4; ++i) rr[384 + lane + 64 * i] = f2bf(x[i] * sc * gkv[i]);
    }
  }
}
DI void phase_rowwise_b(const Params& p, int l, int bid, int nb) {
  const int lane = threadIdx.x & 63, wave = threadIdx.x >> 6;
  const bf16_t* R = ws_b(p, OFF_S1);
  const float2* t32 = (const float2*)(p.ws + OFF_T32);
  const float2* t64 = (const float2*)(p.ws + OFF_T64);
  const int e = lane & 31;
  const int ax32 = e >> 4, hf32 = (e >> 3) & 1, f32i = e & 7;
  const int ax = lane >> 5, hf = (lane >> 4) & 1, f = lane & 15;
  const float gqn = p.g_qn[l * 64 + lane], gkn = p.g_kn[l * 64 + lane];
  for (int row = bid * 4 + wave; row < MROWS; row += nb * 4) {
    const int b = row / TT, t = row % TT;
    const bool latent = t < SEQ;
    const int pr = (t >> 6) & 63, pc = t & 63;
    bf16_t lq[4], lk[4], lg[6];
    const bf16_t lkpe = R[(size_t)row * RW + 640 + e];
    bf16_t* qptr[4]; bf16_t* kptr[4]; bf16_t* gptr[6];
#pragma unroll
    for (int it = 0; it < 4; ++it) {
      const int m = it * 2 + (lane >> 5);
      qptr[it] = qkv(p, Q_C) + ((size_t)(b * 8 + m) * TT + t) * 32 + e;
      kptr[it] = qkv(p, K_C) + ((size_t)(b * 8 + m) * TT + t) * 32 + e;
      lq[it] = latent ? *qptr[it] : (bf16_t)0; lk[it] = latent ? *kptr[it] : (bf16_t)0;
    }
#pragma unroll
    for (int hh = 0; hh < 6; ++hh) {
      gptr[hh] = (hh < 4) ? qkv(p, Q_D) + ((size_t)(b * 4 + hh) * TT + t) * 64 + lane
                          : qkv(p, K_D) + ((size_t)(b * 2 + (hh - 4)) * TT + t) * 64 + lane;
      lg[hh] = *gptr[hh];
    }
    const float2 cs32 = t32[(ax32 ? pc : pr) * 8 + f32i];
    const float2 cs = t64[(ax ? pc : pr) * 16 + f];
    {
      float x = bf2f(lkpe);
      const float pt = __shfl_xor(x, 8);
      if (latent) x = hf32 ? (pt * cs32.y + x * cs32.x) : (x * cs32.x - pt * cs32.y);
      if (lane < 32) {
        const bf16_t o = f2bf(x);
#pragma unroll
        for (int hh = 0; hh < 4; ++hh) qkv(p, K_A)[((size_t)(b * 4 + hh) * TT + t) * 96 + 64 + e] = o;
      }
    }
    if (latent) {
#pragma unroll
      for (int it = 0; it < 4; ++it) {
        const float xq = bf2f(lq[it]), xk = bf2f(lk[it]);
        const float pq = __shfl_xor(xq, 8), pk = __shfl_xor(xk, 8);
        *qptr[it] = f2bf(hf32 ? (pq * cs32.y + xq * cs32.x) : (xq * cs32.x - pq * cs32.y));
        *kptr[it] = f2bf(hf32 ? (pk * cs32.y + xk * cs32.x) : (xk * cs32.x - pk * cs32.y));
      }
    }
    {
#pragma unroll
      for (int hh = 0; hh < 6; ++hh) {
        const float g = (hh < 4) ? gqn : gkn;
        float x = bf2f(lg[hh]);
        const float ss = wave_sum(x * x);
        x = x * rsqrtf(ss * (1.f / 64.f) + EPS) * g;
        const float pt = __shfl_xor(x, 16);
        if (latent) x = hf ? (pt * cs.y + x * cs.x) : (x * cs.x - pt * cs.y);
        *gptr[hh] = f2bf(x);
      }
    }
  }
}

DI void phase_gemm2(const Params& p, int bid, int nb, char* smem) {
  bf16_t* sA = (bf16_t*)smem; bf16_t* sB = sA + 2 * LTILE;
  const int lane = threadIdx.x & 63, wave = threadIdx.x >> 6, wm = wave >> 1, wn = wave & 1, h = lane >> 5;
  const bf16_t* R = ws_b(p, OFF_S1);
  const float2* t32 = (const float2*)(p.ws + OFF_T32);
  for (int idx = bid >> 3; idx < 17 * 7; idx += nb >> 3) {
    int mt, nt; decode_tile(idx, bid & 7, 136, 7, mt, nt);
    f32x16 acc[2][2]; zero_acc(acc);
    if (nt < 3) gemm_accum(acc, R + (size_t)mt * 128 * RW, RW, wb(p, W_QUP) + (size_t)nt * 128 * 384, 384, 6, sA, sB);
    else gemm_accum(acc, R + (size_t)mt * 128 * RW + 384, RW, wb(p, W_KVUP) + (size_t)(nt - 3) * 128 * 256, 256, 4, sA, sB);
    const int hq = opaque(h), lq = opaque(lane & 31);
#pragma unroll
    for (int mi = 0; mi < 2; ++mi)
#pragma unroll
      for (int ni = 0; ni < 2; ++ni) {
        const int row0 = mt * 128 + wm * 64 + mi * 32;
        const int b = row0 / TT, t0 = row0 % TT;
        const f32x16& a = acc[mi][ni];
        if (nt < 3) {
          const int c0 = nt * 128 + wn * 64 + ni * 32;
          const int hh = c0 / 96, d0 = c0 % 96, e = lq;
          bf16_t* dst = qkv(p, Q_A) + ((size_t)(b * 4 + hh) * TT + t0) * 96 + d0 + e;
          if (d0 == 64 && t0 < SEQ) {
            const int ax = e >> 4, hf = (e >> 3) & 1, f = e & 7;
#pragma unroll
            for (int r = 0; r < 16; ++r) {
              const int t = t0 + crow(r, hq);
              const int pos = ax ? (t & 63) : (t >> 6);
              const float2 cs = t32[pos * 8 + f];
              const float x = a[r], pt = __shfl_xor(x, 8);
              dst[(size_t)crow(r, hq) * 96] = f2bf(hf ? (pt * cs.y + x * cs.x) : (x * cs.x - pt * cs.y));
            }
          } else {
#pragma unroll
            for (int r = 0; r < 16; ++r) dst[(size_t)crow(r, hq) * 96] = f2bf(a[r]);
          }
        } else {
          const int c0 = (nt - 3) * 128 + wn * 64 + ni * 32;
          const int hh = c0 >> 7, d0 = c0 & 127, e = lq;
          if (d0 < 64) {
            bf16_t* dst = qkv(p, K_A) + ((size_t)(b * 4 + hh) * TT + t0) * 96 + d0 + e;
#pragma unroll
            for (int r = 0; r < 16; ++r) dst[(size_t)crow(r, hq) * 96] = f2bf(a[r]);
          } else {
            store_tr(qkv(p, V_A), 4, b, t0, hh * 64 + (d0 - 64) + e, hq, a);
          }
        }
      }
  }
}

DI float dot8(const float* qv, uint4 kv) {
  return qv[0] * __uint_as_float(kv.x << 16) + qv[1] * __uint_as_float(kv.x & 0xffff0000u)
       + qv[2] * __uint_as_float(kv.y << 16) + qv[3] * __uint_as_float(kv.y & 0xffff0000u)
       + qv[4] * __uint_as_float(kv.z << 16) + qv[5] * __uint_as_float(kv.z & 0xffff0000u)
       + qv[6] * __uint_as_float(kv.w << 16) + qv[7] * __uint_as_float(kv.w & 0xffff0000u);
}
DI void online_key(float s, const bf16_t* vcol, float& m, float& lsum, float (&o)[16]) {
  if (s > m) {
    const float c = __expf(m - s);
    lsum *= c;
#pragma unroll
    for (int d = 0; d < 16; ++d) o[d] *= c;
    m = s;
  }
  const float pr = __expf(s - m);
  lsum += pr;
#pragma unroll
  for (int d = 0; d < 16; ++d) o[d] += pr * bf2f(vcol[(size_t)d * TT]);
}
template <int DQK>
DI void naive_dense(const bf16_t* q, const bf16_t* K, const bf16_t* Vt, int k0, int k1, float scale, float (&o)[16]) {
  float qv[DQK];
#pragma unroll
  for (int d = 0; d < DQK; ++d) qv[d] = bf2f(q[d]) * scale;
  float m = -1e30f, lsum = 0.f;
#pragma unroll
  for (int d = 0; d < 16; ++d) o[d] = 0.f;
  for (int key = k0; key < k1; ++key) {
    const bf16_t* kr = K + (size_t)key * DQK;
    float s = 0.f;
#pragma unroll
    for (int d8 = 0; d8 < DQK / 8; ++d8) s += dot8(qv + d8 * 8, *(const uint4*)(kr + d8 * 8));
    online_key(s, Vt + key, m, lsum, o);
  }
  const float inv = 1.f / lsum;
#pragma unroll
  for (int d = 0; d < 16; ++d) o[d] *= inv;
}
DI void store_y(bf16_t* y, const float (&o)[16]) {
#pragma unroll
  for (int d8 = 0; d8 < 2; ++d8) {
    uint4 v; v.x = pack2(o[d8 * 8], o[d8 * 8 + 1]); v.y = pack2(o[d8 * 8 + 2], o[d8 * 8 + 3]); v.z = pack2(o[d8 * 8 + 4], o[d8 * 8 + 5]); v.w = pack2(o[d8 * 8 + 6], o[d8 * 8 + 7]);
    *(uint4*)(y + d8 * 8) = v;
  }
}

DI void phase_attn_naive(const Params& p, int l, int bid, int nb) {
  const int tid = threadIdx.x;
  bf16_t* Y = ws_b(p, OFF_S0);
  const int nqb = (l == 0) ? 68 : 64;
  const int nitems = 4 * 4 * 4 * nqb;
  for (int it = bid; it < nitems; it += nb) {
    const int var = it / (16 * nqb), rem = it % (16 * nqb), b = rem / (4 * nqb), rem2 = rem % (4 * nqb), hh = rem2 / nqb, qb = rem2 % nqb;
    const int t = qb * 64 + (tid >> 2), dq = tid & 3;
    const bool latent = t < SEQ;
    const int k0 = latent ? 0 : SEQ, k1 = TT;
    bf16_t* y = Y + (size_t)(b * TT + t) * D + var * 256 + hh * 64 + dq * 16;
    float o[16];
    if (var == 0) {
      naive_dense<96>(qkv(p, Q_A) + ((size_t)(b * 4 + hh) * TT + t) * 96, qkv(p, K_A) + (size_t)(b * 4 + hh) * TT * 96,
                      qkv(p, V_A) + ((size_t)(b * 4 + hh) * 64 + dq * 16) * TT, k0, k1, 0.10206207261596577f, o);
    } else if (var == 3) {
      const int hk = hh >> 1;
      naive_dense<64>(qkv(p, Q_D) + ((size_t)(b * 4 + hh) * TT + t) * 64, qkv(p, K_D) + (size_t)(b * 2 + hk) * TT * 64,
                      qkv(p, V_D) + ((size_t)(b * 2 + hk) * 64 + dq * 16) * TT, k0, k1, 0.125f, o);
    } else if (var == 2) {
      float o2[16];
      const bf16_t* Vt = qkv(p, V_C) + ((size_t)(b * 4 + hh) * 64 + dq * 16) * TT;
      naive_dense<32>(qkv(p, Q_C) + ((size_t)(b * 8 + hh * 2) * TT + t) * 32, qkv(p, K_C) + (size_t)(b * 8 + hh * 2) * TT * 32, Vt, k0, k1, 0.17677669529663687f, o);
      naive_dense<32>(qkv(p, Q_C) + ((size_t)(b * 8 + hh * 2 + 1) * TT + t) * 32, qkv(p, K_C) + (size_t)(b * 8 + hh * 2 + 1) * TT * 32, Vt, k0, k1, 0.17677669529663687f, o2);
      const float lam = ws_f(p, OFF_LAM)[l * 4 + hh];
      float ss = 0.f;
#pragma unroll
      for (int d = 0; d < 16; ++d) { o[d] -= lam * o2[d]; ss += o[d] * o[d]; }
      ss += __shfl_xor(ss, 1); ss += __shfl_xor(ss, 2);
      const float sc = rsqrtf(ss * (1.f / 64.f) + EPS) * (1.f - lam_init_of(l));
#pragma unroll
      for (int d = 0; d < 16; ++d) o[d] *= sc * p.g_sub[l * 64 + dq * 16 + d];
    } else {
      const bf16_t* Kb = qkv(p, K_B) + (size_t)(b * 4 + hh) * TT * 64;
      const bf16_t* Vt = qkv(p, V_B) + ((size_t)(b * 4 + hh) * 64 + dq * 16) * TT;
      const bf16_t* q = qkv(p, Q_B) + ((size_t)(b * 4 + hh) * TT + t) * 64;
      if (!latent) {
        naive_dense<64>(q, Kb, Vt, SEQ, TT, 0.125f, o);
      } else {
        float qv[64];
#pragma unroll
        for (int d = 0; d < 64; ++d) qv[d] = bf2f(q[d]) * 0.125f;
        float m = -1e30f, lsum = 0.f;
#pragma unroll
        for (int d = 0; d < 16; ++d) o[d] = 0.f;
        const int r = t >> 6, w = t & 63;
        const int rs = min(max(r - 4, 0), 56), cs = min(max(w - 8, 0), 48);
        const float* rpb = p.rpb + (size_t)(l * 4 + hh) * 15 * 31;
        for (int kk = 0; kk < 384; ++kk) {
          int key; float bias = 0.f;
          if (kk < 128) { const int i = kk >> 4, j = kk & 15; key = (rs + i) * 64 + cs + j; bias = rpb[(rs + i - r + 7) * 31 + (cs + j - w + 15)]; }
          else key = SEQ + (kk - 128);
          const bf16_t* kr = Kb + (size_t)key * 64;
          float s = 0.f;
#pragma unroll
          for (int d8 = 0; d8 < 8; ++d8) s += dot8(qv + d8 * 8, *(const uint4*)(kr + d8 * 8));
          online_key(s + bias, Vt + key, m, lsum, o);
        }
        const float inv = 1.f / lsum;
#pragma unroll
        for (int d = 0; d < 16; ++d) o[d] *= inv;
      }
    }
    store_y(y, o);
  }
}

struct TileMap { int nfirst, first0, second0, ntiles; };
constexpr int ATT_SV_OFF = 26624, ATT_BIAS_OFF = 44032;

template <int DQK, bool NA>
DI void flash_pass(const bf16_t* __restrict__ Qg, const bf16_t* __restrict__ Kg, const bf16_t* __restrict__ Vg,
                   int q0, TileMap tm, float c, f32x16 (&o)[2], char* smem, const float* sBias) {
  constexpr int KR = DQK + 8, KT = 64 * KR, VR = 68, VT = 64 * VR, NKC = DQK / 32, CPR = DQK / 8;
  bf16_t* sK = (bf16_t*)smem;
  bf16_t* sV = (bf16_t*)(smem + ATT_SV_OFF);
  const int tid = opaque(threadIdx.x), lane = tid & 63, wave = tid >> 6, h = lane >> 5, li = lane & 31;
  bf16x8 qf[DQK / 16];
  {
    const bf16_t* qp = Qg + (size_t)(q0 + wave * 32 + li) * DQK + h * 8;
#pragma unroll
    for (int kk = 0; kk < DQK / 16; ++kk) qf[kk] = *(const bf16x8*)(qp + kk * 16);
  }
#pragma unroll
  for (int mb = 0; mb < 2; ++mb)
#pragma unroll
    for (int r = 0; r < 16; ++r) o[mb][r] = 0.f;
  float m = -1e30f, lsum = 0.f;
  const int r_w = (q0 >> 6) + (wave >> 1), rs_w = min(max(r_w - 4, 0), 56);
  const int w_q = (wave & 1) * 32 + li, cs_q = min(max(w_q - 8, 0), 48);
  uint4 rk0, rk1, rk2, rv0, rv1;
  rk1 = make_uint4(0, 0, 0, 0); rk2 = rk1;
#define KEY0_OF(tile) ((tile) < tm.nfirst ? tm.first0 + (tile) * 64 : tm.second0 + ((tile) - tm.nfirst) * 64)
#define GK(i) *(const uint4*)(Kg + (size_t)key0 * DQK + (tid + 256 * (i)) * 8)
#define GV(i) *(const uint4*)(Vg + (size_t)((tid + 256 * (i)) >> 3) * TT + key0 + ((tid + 256 * (i)) & 7) * 8)
#define GLOAD(tile) { const int key0 = KEY0_OF(tile); rk0 = GK(0); if (NKC > 1) rk1 = GK(1); if (NKC > 2) rk2 = GK(2); rv0 = GV(0); rv1 = GV(1); }
#define WK(buf, i, r) { const int id = tid + 256 * (i); const int row = id / CPR, cc = id % CPR; *(uint4*)(sK + (buf) * KT + row * KR + cc * 8) = r; }
#define WV(buf, i, r) { const int id = tid + 256 * (i); bf16_t* d = sV + (buf) * VT + (id >> 3) * VR + (id & 7) * 8; \
      *(uint2*)d = make_uint2(r.x, r.y); *(uint2*)(d + 4) = make_uint2(r.z, r.w); }
#define LWRITE(buf) { WK(buf, 0, rk0) if (NKC > 1) WK(buf, 1, rk1) if (NKC > 2) WK(buf, 2, rk2) WV(buf, 0, rv0) WV(buf, 1, rv1) }
  GLOAD(0)
  LWRITE(0)
#pragma unroll
  for (int kk = 0; kk < DQK / 16; ++kk) asm volatile("" :: "v"(qf[kk]));
  __syncthreads();
#pragma unroll 1
  for (int tile = 0; tile < tm.ntiles; ++tile) {
    const int cur = tile & 1;
    const bool more = tile + 1 < tm.ntiles;
    if (more) GLOAD(tile + 1)
    bool active = true;
    int kr = 0;
    if (NA && tile >= tm.nfirst) { kr = (tm.second0 >> 6) + (tile - tm.nfirst); active = (kr >= rs_w) && (kr < rs_w + 8); }
    if (active) {
      f32x16 s[2];
      bf16x8 kf[2][DQK / 16];
#pragma unroll
      for (int kb = 0; kb < 2; ++kb) {
#pragma unroll
        for (int r = 0; r < 16; ++r) s[kb][r] = 0.f;
        const bf16_t* kp = sK + cur * KT + (kb * 32 + li) * KR + h * 8;
#pragma unroll
        for (int kk = 0; kk < DQK / 16; ++kk) {
          if (NA) s[kb] = MFMA32(*(const bf16x8*)(kp + kk * 16), qf[kk], s[kb]);
          else kf[kb][kk] = *(const bf16x8*)(kp + kk * 16);
        }
      }
      if (!NA) {
        __builtin_amdgcn_sched_barrier(0);
#pragma unroll
        for (int kk = 0; kk < DQK / 16; ++kk) {
          s[0] = MFMA32(kf[0][kk], qf[kk], s[0]);
          s[1] = MFMA32(kf[1][kk], qf[kk], s[1]);
        }
      }
      bf16x8 vf[2][2][2];
      if (!NA) {
#pragma unroll
      for (int kb = 0; kb < 2; ++kb)
#pragma unroll
        for (int s2 = 0; s2 < 2; ++s2)
#pragma unroll
          for (int mb = 0; mb < 2; ++mb) {
            const bf16_t* vp = sV + cur * VT + (mb * 32 + li) * VR + kb * 32 + 16 * s2 + 4 * h;
            const uint2 lo = *(const uint2*)vp, hi = *(const uint2*)(vp + 8);
            uint4 u; u.x = lo.x; u.y = lo.y; u.z = hi.x; u.w = hi.y;
            vf[kb][s2][mb] = __builtin_bit_cast(bf16x8, u);
          }
      __builtin_amdgcn_sched_barrier(0);
      }
      if (NA && tile >= tm.nfirst) {
        const float* brow = sBias + (kr - r_w + 7) * 31;
#pragma unroll
        for (int kb = 0; kb < 2; ++kb)
#pragma unroll
          for (int r = 0; r < 16; ++r) {
            const int cidx = kb * 32 + crow(r, h);
            const bool ok = (unsigned)(cidx - cs_q) < 16u;
            const int bi = min(max(cidx - w_q + 15, 0), 30);
            s[kb][r] = ok ? s[kb][r] + 8.f * brow[bi] : -1e30f;
          }
      }
      float mx = s[0][0];
#pragma unroll
      for (int kb = 0; kb < 2; ++kb)
#pragma unroll
        for (int r = 0; r < 16; ++r) mx = fmaxf(mx, s[kb][r]);
      mx = xhalf_max(mx);
      const float m_new = fmaxf(m, mx);
      if (__any(m_new > m)) {
        const float alpha = __builtin_amdgcn_exp2f((m - m_new) * c);
        lsum *= alpha;
#pragma unroll
        for (int mb = 0; mb < 2; ++mb)
#pragma unroll
          for (int r = 0; r < 16; ++r) o[mb][r] *= alpha;
        m = m_new;
      }
      const float mc = m * c;
      bf16x8 pf[2][2];
#pragma unroll
      for (int kb = 0; kb < 2; ++kb) {
        float pv[16];
#pragma unroll
        for (int r = 0; r < 16; ++r) { pv[r] = __builtin_amdgcn_exp2f(fmaf(s[kb][r], c, -mc)); lsum += pv[r]; }
#pragma unroll
        for (int s2 = 0; s2 < 2; ++s2) {
          uint4 u;
          u.x = pack2(pv[8 * s2 + 0], pv[8 * s2 + 1]); u.y = pack2(pv[8 * s2 + 2], pv[8 * s2 + 3]);
          u.z = pack2(pv[8 * s2 + 4], pv[8 * s2 + 5]); u.w = pack2(pv[8 * s2 + 6], pv[8 * s2 + 7]);
          pf[kb][s2] = __builtin_bit_cast(bf16x8, u);
        }
      }
#pragma unroll
      for (int kb = 0; kb < 2; ++kb)
#pragma unroll
        for (int s2 = 0; s2 < 2; ++s2)
#pragma unroll
          for (int mb = 0; mb < 2; ++mb) {
            if (NA) {
              const bf16_t* vp = sV + cur * VT + (mb * 32 + li) * VR + kb * 32 + 16 * s2 + 4 * h;
              const uint2 lo = *(const uint2*)vp, hi = *(const uint2*)(vp + 8);
              uint4 u; u.x = lo.x; u.y = lo.y; u.z = hi.x; u.w = hi.y;
              vf[kb][s2][mb] = __builtin_bit_cast(bf16x8, u);
            }
            o[mb] = MFMA32(vf[kb][s2][mb], pf[kb][s2], o[mb]);
          }
    }
    if (more) LWRITE(cur ^ 1)
    __syncthreads();
  }
  lsum = xhalf_sum(lsum);
  const float inv = 1.f / lsum;
#pragma unroll
  for (int mb = 0; mb < 2; ++mb)
#pragma unroll
    for (int r = 0; r < 16; ++r) o[mb][r] *= inv;
}

DI void store_o(bf16_t* dst  , const f32x16 (&o)[2], int h) {
#pragma unroll
  for (int mb = 0; mb < 2; ++mb)
#pragma unroll
    for (int g = 0; g < 4; ++g) {
      uint2 v; v.x = pack2(o[mb][4 * g], o[mb][4 * g + 1]); v.y = pack2(o[mb][4 * g + 2], o[mb][4 * g + 3]);
      *(uint2*)(dst + mb * 32 + 8 * g + 4 * h) = v;
    }
}

template <int VAR>
DI void attn_items(const Params& p, int l, int bid, int nb, char* smem) {
  const int tid = threadIdx.x, lane = tid & 63, wave = tid >> 6, h = lane >> 5, li = lane & 31;
  float* sBias = (float*)(smem + ATT_BIAS_OFF);
  bf16_t* Y = ws_b(p, OFF_S0);
  const int nitems = (l == 0) ? 512 + 32 : 512;
  constexpr float LOG2E = 1.4426950408889634f;
  for (int it0 = bid >> 3; it0 < nitems / 8; it0 += nb >> 3) {
    const int it = (it0 < 64) ? (bid & 7) * 64 + it0 : 512 + (bid & 7) * 4 + (it0 - 64);
    int b, hh, q0; bool latent;
    if (it < 512) { b = it >> 7; hh = (it >> 5) & 3; q0 = (it & 31) * 128; latent = true; }
    else { const int r = it - 512; b = (r >> 3) & 3; hh = (r >> 1) & 3; q0 = SEQ + (r & 1) * 128; latent = false; }
    TileMap tm;
    if (latent) { tm.nfirst = 68; tm.first0 = 0; tm.second0 = 0; tm.ntiles = 68; }
    else { tm.nfirst = 4; tm.first0 = SEQ; tm.second0 = 0; tm.ntiles = 4; }
    bf16_t* y = Y + (size_t)(b * TT + q0 + wave * 32 + li) * D + VAR * 256 + hh * 64;
    f32x16 o[2];
    if (VAR == 0) {
      flash_pass<96, false>(qkv(p, Q_A) + (size_t)(b * 4 + hh) * TT * 96, qkv(p, K_A) + (size_t)(b * 4 + hh) * TT * 96,
                            qkv(p, V_A) + (size_t)(b * 4 + hh) * 64 * TT, q0, tm, 0.10206207261596577f * LOG2E, o, smem, sBias);
    } else if (VAR == 3) {
      const int hk = hh >> 1;
      flash_pass<64, false>(qkv(p, Q_D) + (size_t)(b * 4 + hh) * TT * 64, qkv(p, K_D) + (size_t)(b * 2 + hk) * TT * 64,
                            qkv(p, V_D) + (size_t)(b * 2 + hk) * 64 * TT, q0, tm, 0.125f * LOG2E, o, smem, sBias);
    } else if (VAR == 2) {
      f32x16 o2[2];
      const bf16_t* Vt = qkv(p, V_C) + (size_t)(b * 4 + hh) * 64 * TT;
      flash_pass<32, false>(qkv(p, Q_C) + (size_t)(b * 8 + hh * 2) * TT * 32, qkv(p, K_C) + (size_t)(b * 8 + hh * 2) * TT * 32, Vt, q0, tm, 0.17677669529663687f * LOG2E, o, smem, sBias);
      flash_pass<32, false>(qkv(p, Q_C) + (size_t)(b * 8 + hh * 2 + 1) * TT * 32, qkv(p, K_C) + (size_t)(b * 8 + hh * 2 + 1) * TT * 32, Vt, q0, tm, 0.17677669529663687f * LOG2E, o2, smem, sBias);
      const float lam = ws_f(p, OFF_LAM)[l * 4 + hh];
      float ss = 0.f;
#pragma unroll
      for (int mb = 0; mb < 2; ++mb)
#pragma unroll
        for (int r = 0; r < 16; ++r) { const float v = o[mb][r] - lam * o2[mb][r]; o[mb][r] = v; ss += v * v; }
      ss = xhalf_sum(ss);
      const float sc = rsqrtf(ss * (1.f / 64.f) + EPS) * (1.f - lam_init_of(l));
#pragma unroll
      for (int mb = 0; mb < 2; ++mb)
#pragma unroll
        for (int r = 0; r < 16; ++r) o[mb][r] *= sc * p.g_sub[l * 64 + mb * 32 + crow(r, h)];
    } else {
      const bf16_t* Qb = qkv(p, Q_B) + (size_t)(b * 4 + hh) * TT * 64;
      const bf16_t* Kb = qkv(p, K_B) + (size_t)(b * 4 + hh) * TT * 64;
      const bf16_t* Vt = qkv(p, V_B) + (size_t)(b * 4 + hh) * 64 * TT;
      if (latent) {
        for (int i = tid; i < 465; i += NTHREADS) sBias[i] = p.rpb[(size_t)(l * 4 + hh) * 465 + i];
        const int r0 = q0 >> 6;
        const int rs0 = min(max(r0 - 4, 0), 56), rs1 = min(max(r0 + 1 - 4, 0), 56);
        tm.nfirst = 4; tm.first0 = SEQ; tm.second0 = rs0 * 64; tm.ntiles = 4 + (rs1 - rs0) + 8;
        flash_pass<64, true>(Qb, Kb, Vt, q0, tm, 0.125f * LOG2E, o, smem, sBias);
      } else {
        flash_pass<64, false>(Qb, Kb, Vt, q0, tm, 0.125f * LOG2E, o, smem, sBias);
      }
    }
    store_o(y, o, h);
  }
}
DI void phase_attn(const Params& p, int l, int bid, int nb, char* smem) {
  attn_items<2>(p, l, bid, nb, smem);
  attn_items<0>(p, l, bid, nb, smem);
  attn_items<3>(p, l, bid, nb, smem);
  attn_items<1>(p, l, bid, nb, smem);
}

DI void phase_merge(const Params& p, int l, int bid, int nb, char* smem) {
  bf16_t* sA = (bf16_t*)smem; bf16_t* sB = sA + 2 * LTILE;
  const bf16_t* H = ws_b(p, OFF_H);
  const bf16_t* Y = ws_b(p, OFF_S0);
  bf16_t* ACC = ws_b(p, OFF_S1);
  for (int idx = bid >> 3; idx < 16 * 8; idx += nb >> 3) {
    int mtl, nt; decode_tile(idx, bid & 7, 128, 8, mtl, nt);
    const int mt = map_mtile(mtl, true);
    f32x16 acc[2][2]; zero_acc(acc);
#pragma unroll 1
    for (int i = 0; i < 4; ++i) {
      unsigned pp[2][2][8];
      {
        f32x16 ap[2][2]; zero_acc(ap);
        gemm_accum_lite(ap, Y + (size_t)mt * 128 * D + i * 256, D, wb(p, W_BR) + ((size_t)i * 1024 + nt * 128) * 256, 256, 4, sA, sB);
#pragma unroll
        for (int a = 0; a < 2; ++a)
#pragma unroll
          for (int c = 0; c < 2; ++c)
#pragma unroll
            for (int r = 0; r < 8; ++r) pp[a][c][r] = pack2(ap[a][c][2 * r], ap[a][c][2 * r + 1]);
      }
      f32x16 ag[2][2]; zero_acc(ag);
      gemm_accum_lite(ag, H + (size_t)mt * 128 * D, D, wb(p, W_IN) + (size_t)(NPROJ + i * 1024 + nt * 128) * 1024, 1024, 16, sA, sB);
#pragma unroll
      for (int a = 0; a < 2; ++a)
#pragma unroll
        for (int c = 0; c < 2; ++c)
#pragma unroll
          for (int r = 0; r < 8; ++r) {
            acc[a][c][2 * r] += __uint_as_float(pp[a][c][r] << 16) / (1.f + __expf(-ag[a][c][2 * r]));
            acc[a][c][2 * r + 1] += __uint_as_float(pp[a][c][r] & 0xffff0000u) / (1.f + __expf(-ag[a][c][2 * r + 1]));
          }
    }
    const int t2 = opaque(threadIdx.x), wm = t2 >> 7, wn = (t2 >> 6) & 1, hq = (t2 >> 5) & 1, lq = t2 & 31;
#pragma unroll
    for (int mi = 0; mi < 2; ++mi)
#pragma unroll
      for (int ni = 0; ni < 2; ++ni) {
        bf16_t* dst = ACC + (size_t)(mt * 128 + wm * 64 + mi * 32) * D + nt * 128 + wn * 64 + ni * 32 + lq;
#pragma unroll
        for (int r = 0; r < 16; ++r) dst[(size_t)crow(r, hq) * D] = f2bf(acc[mi][ni][r]);
      }
  }
  if (l == 0) {
    for (int u = (nb - 1 - bid); u < 128; u += nb) {
      const int c = u & 7, nt = u >> 3;
      const int mt = (c >> 1) * 34 + 32 + (c & 1);
      f32x16 acc[2];
#pragma unroll
      for (int a = 0; a < 2; ++a)
#pragma unroll
        for (int r = 0; r < 16; ++r) acc[a][r] = 0.f;
#pragma unroll 1
      for (int i = 0; i < 4; ++i) {
        f32x16 ap[2], ag[2];
#pragma unroll
        for (int a = 0; a < 2; ++a)
#pragma unroll
          for (int r = 0; r < 16; ++r) { ap[a][r] = 0.f; ag[a][r] = 0.f; }
        gemm_accum_n64(ap, Y + (size_t)mt * 128 * D + i * 256, D, wb(p, W_BR) + ((size_t)i * 1024 + nt * 64) * 256, 256, 4, sA, sB);
        gemm_accum_n64(ag, H + (size_t)mt * 128 * D, D, wb(p, W_IN) + (size_t)(NPROJ + i * 1024 + nt * 64) * 1024, 1024, 16, sA, sB);
#pragma unroll
        for (int a = 0; a < 2; ++a)
#pragma unroll
          for (int r = 0; r < 16; ++r) acc[a][r] += ap[a][r] / (1.f + __expf(-ag[a][r]));
      }
      const int t2 = opaque(threadIdx.x), wm = t2 >> 7, wn = (t2 >> 6) & 1, hq = (t2 >> 5) & 1, lq = t2 & 31;
#pragma unroll
      for (int mi = 0; mi < 2; ++mi) {
        bf16_t* dst = ACC + (size_t)(mt * 128 + wm * 64 + mi * 32) * D + nt * 64 + wn * 32 + lq;
#pragma unroll
        for (int r = 0; r < 16; ++r) dst[(size_t)crow(r, hq) * D] = f2bf(acc[mi][r]);
      }
    }
  }
}

DI void phase_gemm_plain(const Params& p, int l, int bid, int nb, char* smem, const bf16_t* A, int lda, int nk, const bf16_t* Wt, bf16_t* O) {
  {
    bf16_t* sA = (bf16_t*)smem; bf16_t* sB = sA + 2 * WA_STG;
    for (int idx = bid >> 3; idx < 16 * 4; idx += nb >> 3) {
      int mtl, nt; decode_tile(idx, bid & 7, 128, 4, mtl, nt);
      const int mt = map_mtile(mtl, true);
      f32x16 acc[2][4];
#pragma unroll
      for (int a = 0; a < 2; ++a)
#pragma unroll
        for (int c = 0; c < 4; ++c)
#pragma unroll
          for (int r = 0; r < 16; ++r) acc[a][c][r] = 0.f;
      gemm_accum_wide(acc, A + (size_t)mt * 128 * lda, lda, Wt + (size_t)nt * 256 * lda, lda, nk * 2, sA, sB);
      const int t2 = opaque(threadIdx.x), wm = t2 >> 7, wn = (t2 >> 6) & 1, hq = (t2 >> 5) & 1, lq = t2 & 31;
#pragma unroll
      for (int mi = 0; mi < 2; ++mi)
#pragma unroll
        for (int ni = 0; ni < 4; ++ni) {
          bf16_t* dst = O + (size_t)(mt * 128 + wm * 64 + mi * 32) * D + nt * 256 + wn * 128 + ni * 32 + lq;
#pragma unroll
          for (int r = 0; r < 16; ++r) dst[(size_t)crow(r, hq) * D] = f2bf(acc[mi][ni][r]);
        }
    }
  }
  bf16_t* sA = (bf16_t*)smem; bf16_t* sB = sA + 2 * LTILE;
  const int lane = threadIdx.x & 63, wave = threadIdx.x >> 6, wm = wave >> 1, wn = wave & 1, h = lane >> 5;
  if (l == 0) {
    for (int u = (nb - 1 - bid); u < 128; u += nb) {
      const int c = u & 7, nt64 = u >> 3;
      const int mt = (c >> 1) * 34 + 32 + (c & 1);
      f32x16 acc[2];
#pragma unroll
      for (int a = 0; a < 2; ++a)
#pragma unroll
        for (int r = 0; r < 16; ++r) acc[a][r] = 0.f;
      gemm_accum_n64(acc, A + (size_t)mt * 128 * lda, lda, Wt + (size_t)nt64 * 64 * lda, lda, nk, sA, sB);
      const int hq = opaque(h), lq = opaque(lane & 31);
#pragma unroll
      for (int mi = 0; mi < 2; ++mi) {
        bf16_t* dst = O + (size_t)(mt * 128 + wm * 64 + mi * 32) * D + nt64 * 64 + wn * 32 + lq;
#pragma unroll
        for (int r = 0; r < 16; ++r) dst[(size_t)crow(r, hq) * D] = f2bf(acc[mi][r]);
      }
    }
  }
}

DI void phase_gemm4(const Params& p, int l, int bid, int nb, char* smem) {
  bf16_t* sA = (bf16_t*)smem; bf16_t* sB = sA + 2 * WA_STG;
  const bf16_t* H = ws_b(p, OFF_H);
  bf16_t* ACT = ws_b(p, OFF_X2);
  const bool lat = (l == 1);
  const int nmt = lat ? 128 : 136;
  for (int idx = bid >> 3; idx < (nmt >> 3) * 22; idx += nb >> 3) {
    int mtl, nt; decode_tile(idx, bid & 7, nmt, 22, mtl, nt);
    const int mt = map_mtile(mtl, lat);
    f32x16 acc[2][4];
#pragma unroll
    for (int a = 0; a < 2; ++a)
#pragma unroll
      for (int c = 0; c < 4; ++c)
#pragma unroll
        for (int r = 0; r < 16; ++r) acc[a][c][r] = 0.f;
    gemm_accum_wide(acc, H + (size_t)mt * 128 * D, D, wb(p, W_GU) + (size_t)nt * 256 * 1024, 1024, 32, sA, sB);
    const int t2 = opaque(threadIdx.x), wm = t2 >> 7, wn = (t2 >> 6) & 1, hq = (t2 >> 5) & 1, lq = t2 & 31;
#pragma unroll
    for (int mi = 0; mi < 2; ++mi)
#pragma unroll
      for (int j = 0; j < 2; ++j) {
        bf16_t* dst = ACT + (size_t)(mt * 128 + wm * 64 + mi * 32) * DFF + (nt * 4 + wn * 2 + j) * 32 + lq;
#pragma unroll
        for (int r = 0; r < 16; ++r) {
          const float g = acc[mi][2 * j][r], u = acc[mi][2 * j + 1][r];
          dst[(size_t)crow(r, hq) * DFF] = f2bf(g / (1.f + __expf(-g)) * u);
        }
      }
  }
}

DI void phase_ln(const Params& p, int l, int bid, int nb, const bf16_t* O, int gate_off, const float* lng, const float* lnb, int hl, int hsh_off, int hsc_off, bool src_is_input) {
  const int lane = threadIdx.x & 63, wave = threadIdx.x >> 6;
  bf16_t* H = ws_b(p, OFF_H);
  const float* mod = ws_f(p, OFF_MOD);
  float4 lg[4], lb[4];
#pragma unroll
  for (int i = 0; i < 4; ++i) { const int c = (i * 64 + lane) * 4; lg[i] = *(const float4*)(lng + c); lb[i] = *(const float4*)(lnb + c); }
  const int stride = nb * 4;
  for (int row0 = bid * 4 + wave; row0 < MROWS; row0 += 2 * stride) {
    int rw[2], bb[2], tt[2]; bool ok[2];
#pragma unroll
    for (int k = 0; k < 2; ++k) {
      rw[k] = row0 + k * stride;
      const int rr = min(rw[k], MROWS - 1);
      bb[k] = rr / TT; tt[k] = rr % TT;
      ok[k] = (rw[k] < MROWS) && !(l == 1 && tt[k] >= SEQ);
    }
    float v[2][16];
    float s[2] = {0.f, 0.f};
#pragma unroll
    for (int k = 0; k < 2; ++k) {
      if (!ok[k]) continue;
      const int j = tt[k] < SEQ ? bb[k] : 4;
      const float* src = xsrc_row(p, src_is_input ? 0 : 1, bb[k], tt[k]);
      const float* mg = mod + (size_t)(l * 5 + j) * 6144 + gate_off;
#pragma unroll
      for (int i = 0; i < 4; ++i) {
        const int c = (i * 64 + lane) * 4;
        const float4 x = *(const float4*)(src + c);
        const float4 g = *(const float4*)(mg + c);
        const uint2 ob = *(const uint2*)(O + (size_t)rw[k] * D + c);
        v[k][i * 4 + 0] = ALPHA * x.x + g.x * __uint_as_float(ob.x << 16);
        v[k][i * 4 + 1] = ALPHA * x.y + g.y * __uint_as_float(ob.x & 0xffff0000u);
        v[k][i * 4 + 2] = ALPHA * x.z + g.z * __uint_as_float(ob.y << 16);
        v[k][i * 4 + 3] = ALPHA * x.w + g.w * __uint_as_float(ob.y & 0xffff0000u);
        s[k] += v[k][i * 4] + v[k][i * 4 + 1] + v[k][i * 4 + 2] + v[k][i * 4 + 3];
      }
    }
    float mu[2], rstd[2];
#pragma unroll
    for (int k = 0; k < 2; ++k) mu[k] = wave_sum(s[k]) * (1.f / 1024.f);
    float q[2] = {0.f, 0.f};
#pragma unroll
    for (int k = 0; k < 2; ++k)
#pragma unroll
      for (int i = 0; i < 16; ++i) { v[k][i] -= mu[k]; q[k] += v[k][i] * v[k][i]; }
#pragma unroll
    for (int k = 0; k < 2; ++k) rstd[k] = rsqrtf(wave_sum(q[k]) * (1.f / 1024.f) + EPS);
#pragma unroll
    for (int k = 0; k < 2; ++k) {
      if (!ok[k]) continue;
      const int j = tt[k] < SEQ ? bb[k] : 4;
      float* dst = xdst_row(p, bb[k], tt[k]);
      const float* mh = (hl >= 0) ? mod + (size_t)(hl * 5 + j) * 6144 : mod;
#pragma unroll
      for (int i = 0; i < 4; ++i) {
        const int c = (i * 64 + lane) * 4;
        float4 y;
        y.x = v[k][i * 4 + 0] * rstd[k] * lg[i].x + lb[i].x; y.y = v[k][i * 4 + 1] * rstd[k] * lg[i].y + lb[i].y;
        y.z = v[k][i * 4 + 2] * rstd[k] * lg[i].z + lb[i].z; y.w = v[k][i * 4 + 3] * rstd[k] * lg[i].w + lb[i].w;
        *(float4*)(dst + c) = y;
        if (hl >= 0) {
          const float4 sh = *(const float4*)(mh + hsh_off + c);
          const float4 sc = *(const float4*)(mh + hsc_off + c);
          store_h4(H + (size_t)rw[k] * D + c, y.x * (1.f + sc.x) + sh.x, y.y * (1.f + sc.y) + sh.y, y.z * (1.f + sc.z) + sh.z, y.w * (1.f + sc.w) + sh.w);
        }
      }
    }
  }
}

#define XB_TMO      128
#define XB_XCNT(j)  (256  + 64 * (j))
#define XB_XSUB(j)  (1280 + 64 * (j))
#define XB_XGEN(j)  (2304 + 64 * (j))
#define XB_TOP      3328
#define XB_TOPGEN   3392
#define XCD_BAR_WORDS 3456
#define XB_SPIN_CAP (1u << 18)
#define LAS __attribute__((address_space(3)))
DI unsigned xb_ld(unsigned* p)              { return __hip_atomic_load(p, __ATOMIC_RELAXED, __HIP_MEMORY_SCOPE_AGENT); }
DI unsigned xb_add(unsigned* p, unsigned v) { return __hip_atomic_fetch_add(p, v, __ATOMIC_RELAXED, __HIP_MEMORY_SCOPE_AGENT); }
DI unsigned xb_xcc_id() { return (unsigned)__builtin_amdgcn_s_getreg((3 << 11) | 20) & 0xFu; }
#define XB_SPIN(cond, bar) do { unsigned _sp = 0; while (cond) { __builtin_amdgcn_s_sleep(1); \
    if ((++_sp & 255u) == 0u) { if (xb_ld(&(bar)[XB_TMO])) break; if (_sp > XB_SPIN_CAP) { atomicAdd(&(bar)[XB_TMO], 1u); break; } } } } while (0)
struct XcdBarrier { unsigned* bar; unsigned x; volatile LAS unsigned* st; };
DI XcdBarrier xcd_barrier_post(unsigned* bar, volatile LAS unsigned* st) {
  XcdBarrier b; b.bar = bar; b.x = xb_xcc_id(); b.st = st;
  if (threadIdx.x == 0) (void)xb_add(&bar[XB_XCNT(b.x)], 1u);
  return b;
}
DI void xcd_barrier_complete(unsigned* bar, unsigned x, unsigned& nloc, unsigned& nx) {
  const unsigned G = gridDim.x * gridDim.y * gridDim.z;
  unsigned sum, cnt, mine, sp = 0u;
  for (;;) {
    sum = 0u; cnt = 0u; mine = 0u;
#pragma unroll
    for (unsigned j = 0; j < 16; ++j) { const unsigned c = xb_ld(&bar[XB_XCNT(j)]); sum += c; cnt += (c > 0u) ? 1u : 0u; mine = (j == x) ? c : mine; }
    if (sum == G) break;
    __builtin_amdgcn_s_sleep(1);
    if ((++sp & 255u) == 0u) { if (xb_ld(&bar[XB_TMO])) break; if (sp > XB_SPIN_CAP) { atomicAdd(&bar[XB_TMO], 1u); break; } }
  }
  nloc = mine > 0u ? mine : 1u; nx = cnt > 0u ? cnt : 1u;
}
DI void xcd_barrier(const XcdBarrier& b) {
  asm volatile("s_waitcnt vmcnt(0)" ::: "memory");
  __syncthreads();
  if (threadIdx.x == 0) {
    unsigned* bar = b.bar;
    __builtin_amdgcn_s_waitcnt(0);
    unsigned nloc = b.st[0], nx = b.st[1];
    if (nloc == 0u) { xcd_barrier_complete(bar, b.x, nloc, nx); b.st[0] = nloc; b.st[1] = nx; }
    const unsigned old = xb_add(&bar[XB_XSUB(b.x)], 1u);
    const unsigned gen = old / nloc;
    if (old + 1u == (gen + 1u) * nloc) {
      __builtin_amdgcn_fence(__ATOMIC_RELEASE, "agent");
      asm volatile("s_waitcnt vmcnt(0)" ::: "memory");
      const unsigned og = xb_add(&bar[XB_TOP], 1u);
      const unsigned tg = og / nx;
      if (og + 1u == (tg + 1u) * nx) xb_add(&bar[XB_TOPGEN], 1u);
      else XB_SPIN(xb_ld(&bar[XB_TOPGEN]) == tg, bar);
      __builtin_amdgcn_fence(__ATOMIC_ACQUIRE, "agent");
      xb_add(&bar[XB_XGEN(b.x)], 1u);
      asm volatile("s_waitcnt vmcnt(0)" ::: "memory");
    } else {
      XB_SPIN(xb_ld(&bar[XB_XGEN(b.x)]) == gen, bar);
      __builtin_amdgcn_fence(__ATOMIC_ACQUIRE, "agent");
      asm volatile("s_waitcnt vmcnt(0)" ::: "memory");
    }
  }
  __syncthreads();
}

constexpr int NPHASES = 22;
#ifndef REPEAT_MASK
#define REPEAT_MASK 0
#endif
#define PHSLOT(idx) ((idx) < 2 ? (idx) : 2 + ((idx) - 2) % 10)
DI int nrep_of(int flag) { int n = 1 + flag; asm volatile("" : "+s"(n)); return n; }
#define PHASE(idx, body) if (ph_begin <= (idx) && (idx) < ph_end) { for (int rep_ = 0, nrep_ = nrep_of((REPEAT_MASK >> PHSLOT(idx)) & 1); rep_ < nrep_; ++rep_) { body; } if ((idx) + 1 < ph_end) { if (ph_end > NPHASES) grid.sync(); else xcd_barrier(xb); } }
template <int L>
DI void run_layer(const Params& p, int ph_begin, int ph_end, int bid, int nb, char* smem, cg::grid_group& grid, const XcdBarrier& xb) {
  constexpr int base = 2 + 10 * L;
  PHASE(base + 0, phase_gemm1(p, bid, nb, smem))
  PHASE(base + 1, phase_rowwise(p, L, bid, nb))
  PHASE(base + 2, { phase_gemm2(p, bid, nb, smem); phase_rowwise_b(p, L, bid, nb); })
  #if NAIVE_ATTN
  PHASE(base + 3, phase_attn_naive(p, L, bid, nb))
#else
  PHASE(base + 3, phase_attn(p, L, bid, nb, smem))
#endif
  PHASE(base + 4, phase_merge(p, L, bid, nb, smem))
  PHASE(base + 5, phase_gemm_plain(p, L, bid, nb, smem, ws_b(p, OFF_S1), 1024, 16, wb(p, W_OUT), ws_b(p, OFF_S0)))
  PHASE(base + 6, phase_ln(p, L, bid, nb, ws_b(p, OFF_S0), 2048, p.ln1_g + L * D, p.ln1_b + L * D, L, 3072, 4096, L == 0))
  PHASE(base + 7, phase_gemm4(p, L, bid, nb, smem))
  PHASE(base + 8, phase_gemm_plain(p, L, bid, nb, smem, ws_b(p, OFF_X2), DFF, 44, wb(p, W_DN), ws_b(p, OFF_S1)))
  PHASE(base + 9, { phase_ln(p, L, bid, nb, ws_b(p, OFF_S1), 5120, p.ln2_g + L * D, p.ln2_b + L * D, (L == 0) ? 1 : -1, 0, 1024, false);
                    if (L == 0) convert_weights(p, 1, bid, nb, smem); })
}
__global__ void __launch_bounds__(NTHREADS, 2) mega(Params p, int ph_begin, int ph_end) {
  __shared__ __attribute__((aligned(1024))) char smem[73728];
  cg::grid_group grid = cg::this_grid();
  const int bid = blockIdx.x, nb = gridDim.x;
  __shared__ uint4 xb_words;
  if (threadIdx.x == 0) xb_words = make_uint4(0u, 0u, 0u, 0u);
  __syncthreads();
  const XcdBarrier xb = xcd_barrier_post((unsigned*)(p.ws + OFF_BAR), (volatile LAS unsigned*)&xb_words);
  PHASE(0, phase_prologue(p, bid, nb, smem))
  PHASE(1, phase_modulate0(p, bid, nb))
  run_layer<0>(p, ph_begin, ph_end, bid, nb, smem, grid, xb);
  run_layer<1>(p, ph_begin, ph_end, bid, nb, smem, grid, xb);
}

extern "C" void kernel_launch(void* const* d_in, const int* in_sizes, int n_in, void* d_out, int out_size, void* d_ws, size_t ws_size, hipStream_t stream) {
  Params p{};
  const float** pp = (const float**)&p;
  for (int i = 0; i < 27; ++i) pp[i] = (const float*)d_in[i];
  p.out = (float*)d_out;
  p.ws = (char*)d_ws;
  static int grid_blocks = 0;
  if (!grid_blocks) {
    int dev = 0, cus = 0, per_cu = 0;
    hipGetDevice(&dev);
    hipDeviceGetAttribute(&cus, hipDeviceAttributeMultiprocessorCount, dev);
    hipOccupancyMaxActiveBlocksPerMultiprocessor(&per_cu, mega, NTHREADS, 0);
    if (per_cu < 1) per_cu = 1;
    grid_blocks = cus * per_cu;
  }
  hipMemsetAsync((char*)d_ws + OFF_BAR, 0, (XCD_BAR_WORDS + 128) * 4, stream);
#if COOP
  int b = 0, e = NPHASES;
  void* args[] = {&p, &b, &e};
  hipError_t err = hipLaunchCooperativeKernel((void*)mega, dim3(grid_blocks), dim3(NTHREADS), args, 0, stream);
  if (err != hipSuccess) fprintf(stderr, "cooperative launch failed: %s (grid %d)\n", hipGetErrorString(err), grid_blocks);
#else
  for (int ph = 0; ph < NPHASES; ++ph) mega<<<grid_blocks, NTHREADS, 0, stream>>>(p, ph, ph + 1);
#endif
}
```

```cpp
#include <hip/hip_runtime.h>
#include <hip/hip_cooperative_groups.h>
#include <cstdio>
namespace cg = cooperative_groups;

#ifndef COOP
#define COOP 1
#endif
#ifndef NAIVE_ATTN
#define NAIVE_ATTN 0
#endif

#define DI __device__ __forceinline__
typedef unsigned short bf16_t;
using bf16x8 = __attribute__((ext_vector_type(8))) short;
using f32x16 = __attribute__((ext_vector_type(16))) float;
#define MFMA32(a, b, c) __builtin_amdgcn_mfma_f32_32x32x16_bf16((a), (b), (c), 0, 0, 0)

constexpr int D = 1024, NB = 4, SEQ = 4096, CTX = 256, TT = 4352, MROWS = 17408;
constexpr int DIN = 6816, NPROJ = 2720, DFF = 2816, RW = 672;
constexpr float EPS = 1e-6f;
constexpr float ALPHA = 1.4142135623730951f;
constexpr int NTHREADS = 256;

constexpr size_t OFF_MOD = 0;
constexpr size_t OFF_T32 = OFF_MOD + 245760;
constexpr size_t OFF_T64 = OFF_T32 + 4096;
constexpr size_t OFF_LAM = OFF_T64 + 8192;
constexpr size_t OFF_XC  = OFF_LAM + 256;
constexpr size_t OFF_WB  = OFF_XC + 4194304;
constexpr size_t W_IN = 0, W_QUP = 6979584, W_KVUP = 7127040, W_BR = 7258112, W_OUT = 8306688, W_GU = 9355264, W_DN = 15122432, W_END = 18006016;
constexpr size_t OFF_H   = OFF_WB + W_END * 2;
constexpr size_t OFF_S0  = OFF_H + 35651584;
constexpr size_t OFF_S1  = OFF_S0 + 35651584;
constexpr size_t OFF_X2  = OFF_S1 + 35651584;
constexpr size_t OFF_BAR = OFF_X2 + 106954752;
constexpr int XCD_BAR_WORDS_C = 3456;
constexpr size_t E64 = 4456448, E96 = 6684672, E2H = 2228224;
constexpr size_t Q_A = 0, K_A = E96, V_A = 2 * E96, Q_B = V_A + E64, K_B = Q_B + E64, V_B = K_B + E64,
                 Q_C = V_B + E64, K_C = Q_C + E64, V_C = K_C + E64, Q_D = V_C + E64, K_D = Q_D + E64, V_D = K_D + E2H;

struct Params {
  const float *x, *c, *ctx, *c_ctx, *w_ada, *b_ada, *w_in, *g_q_a, *w_q_up, *g_kv_a, *w_kv_up, *rpb,
      *lam_q1, *lam_k1, *lam_q2, *lam_k2, *g_sub, *g_qn, *g_kn, *w_branch, *w_out, *ln1_g, *ln1_b,
      *w_gate_up, *w_down, *ln2_g, *ln2_b;
  float* out;
  char* ws;
};

DI float bf2f(bf16_t b) { return __uint_as_float(((unsigned)b) << 16); }
DI bf16_t f2bf(float x) { return __builtin_bit_cast(unsigned short, (__bf16)x); }
typedef __bf16 bf16x2_t __attribute__((ext_vector_type(2)));
typedef float f32x2_t __attribute__((ext_vector_type(2)));
DI unsigned pack2(float a, float b) { f32x2_t v = {a, b}; return __builtin_bit_cast(unsigned, __builtin_convertvector(v, bf16x2_t)); }
DI float xhalf_max(float x) { auto r = __builtin_amdgcn_permlane32_swap(__float_as_uint(x), __float_as_uint(x), false, false); return fmaxf(__uint_as_float(r[0]), __uint_as_float(r[1])); }
DI float xhalf_sum(float x) { auto r = __builtin_amdgcn_permlane32_swap(__float_as_uint(x), __float_as_uint(x), false, false); return __uint_as_float(r[0]) + __uint_as_float(r[1]); }
template <int CTRL> DI float dpp_mov(float x) { return __int_as_float(__builtin_amdgcn_update_dpp(0, __float_as_int(x), CTRL, 0xF, 0xF, true)); }
DI float xhalf_sum(float x);
DI float wave_sum(float v) {
  v += dpp_mov<0xB1>(v);
  v += dpp_mov<0x4E>(v);
  v += dpp_mov<0x141>(v);
  v += dpp_mov<0x140>(v);
  v += __shfl_xor(v, 16);
  return xhalf_sum(v);
}
DI int opaque(int x) { asm volatile("" : "+v"(x)); return x; }
DI int crow(int reg, int h) { return (reg & 3) + 8 * (reg >> 2) + 4 * h; }
DI float lam_init_of(int l) { return l == 0 ? 0.2f : 0.35550907f; }

DI float* ws_f(const Params& p, size_t off) { return (float*)(p.ws + off); }
DI bf16_t* ws_b(const Params& p, size_t off) { return (bf16_t*)(p.ws + off); }
DI bf16_t* qkv(const Params& p, size_t eoff) { return (bf16_t*)(p.ws + OFF_X2) + eoff; }
DI bf16_t* wb(const Params& p, size_t eoff) { return (bf16_t*)(p.ws + OFF_WB) + eoff; }

DI const float* xsrc_row(const Params& p, int l, int b, int t) {
  if (l == 0) return t < SEQ ? p.x + ((size_t)b * SEQ + t) * D : p.ctx + ((size_t)b * CTX + (t - SEQ)) * D;
  return t < SEQ ? p.out + ((size_t)b * SEQ + t) * D : ws_f(p, OFF_XC) + ((size_t)b * CTX + (t - SEQ)) * D;
}
DI float* xdst_row(const Params& p, int b, int t) {
  return t < SEQ ? p.out + ((size_t)b * SEQ + t) * D : ws_f(p, OFF_XC) + ((size_t)b * CTX + (t - SEQ)) * D;
}

DI void conv_unit(const float* __restrict__ src, int ld_src, int k0, int n0, bf16_t* __restrict__ dst, int ld_dst, int ndst0, float* tile) {
  const int tid = threadIdx.x;
  {
    const int n = tid & 31, kb = tid >> 5;
    float v[16];
#pragma unroll
    for (int i = 0; i < 16; ++i) v[i] = src[(size_t)(k0 + kb + 8 * i) * ld_src + n0 + n];
#pragma unroll
    for (int i = 0; i < 16; ++i) tile[(kb + 8 * i) * 33 + n] = v[i];
  }
  __syncthreads();
  {
    const int nn = tid >> 3, kc = tid & 7;
    float v[16];
#pragma unroll
    for (int j = 0; j < 16; ++j) v[j] = tile[(kc * 16 + j) * 33 + nn];
    uint4 o0, o1;
    o0.x = pack2(v[0], v[1]); o0.y = pack2(v[2], v[3]); o0.z = pack2(v[4], v[5]); o0.w = pack2(v[6], v[7]);
    o1.x = pack2(v[8], v[9]); o1.y = pack2(v[10], v[11]); o1.z = pack2(v[12], v[13]); o1.w = pack2(v[14], v[15]);
    bf16_t* d = dst + (size_t)(ndst0 + nn) * ld_dst + k0 + kc * 16;
    *(uint4*)d = o0; *(uint4*)(d + 8) = o1;
  }
  __syncthreads();
}

DI void convert_weights(const Params& p, int l, int bid, int nb, char* smem) {
  float* tile = (float*)smem;
  int* s_u = (int*)(smem + 128 * 33 * 4);
  unsigned* ctr = (unsigned*)(p.ws + OFF_BAR) + XCD_BAR_WORDS_C + 64 * l;
  for (;;) {
    if (threadIdx.x == 0) *s_u = (int)__hip_atomic_fetch_add(ctr, 1u, __ATOMIC_RELAXED, __HIP_MEMORY_SCOPE_AGENT);
    __syncthreads();
    const int u = *s_u;
    __syncthreads();
    if (u >= 4396) break;
    int v = u;
    if (v < 1704) { int kt = v / 213, nt = v % 213; conv_unit(p.w_in + (size_t)l * 1024 * DIN, DIN, kt * 128, nt * 32, wb(p, W_IN), 1024, nt * 32, tile); continue; }
    v -= 1704;
    if (v < 36) { int kt = v / 12, nt = v % 12; conv_unit(p.w_q_up + (size_t)l * 384 * 384, 384, kt * 128, nt * 32, wb(p, W_QUP), 384, nt * 32, tile); continue; }
    v -= 36;
    if (v < 32) { int kt = v / 16, nt = v % 16; conv_unit(p.w_kv_up + (size_t)l * 256 * 512, 512, kt * 128, nt * 32, wb(p, W_KVUP), 256, nt * 32, tile); continue; }
    v -= 32;
    if (v < 256) { int i = v / 64, r = v % 64, kt = r / 32, nt = r % 32;
      conv_unit(p.w_branch + (size_t)(l * 4 + i) * 256 * 1024, 1024, kt * 128, nt * 32, wb(p, W_BR) + (size_t)i * 1024 * 256, 256, nt * 32, tile); continue; }
    v -= 256;
    if (v < 256) { int kt = v / 32, nt = v % 32; conv_unit(p.w_out + (size_t)l * 1024 * 1024, 1024, kt * 128, nt * 32, wb(p, W_OUT), 1024, nt * 32, tile); continue; }
    v -= 256;
    if (v < 1408) { int kt = v / 176, nt = v % 176; int nd = (nt < 88) ? nt * 64 : (nt - 88) * 64 + 32;
      conv_unit(p.w_gate_up + (size_t)l * 1024 * 5632, 5632, kt * 128, nt * 32, wb(p, W_GU), 1024, nd, tile); continue; }
    v -= 1408;
    { int kt = v / 32, nt = v % 32; conv_unit(p.w_down + (size_t)l * DFF * 1024, 1024, kt * 128, nt * 32, wb(p, W_DN), DFF, nt * 32, tile); }
  }
}

DI void phase_prologue(const Params& p, int bid, int nb, char* smem) {
  const int tid = threadIdx.x;
  float* sc = (float*)smem;
  float* red = sc + 5120;
  if (bid < 384) {
    for (int i = tid; i < 5120; i += NTHREADS) {
      const int j = i >> 10, k = i & 1023;
      const float v = (j < 4) ? p.c[j * 1024 + k] : p.c_ctx[k];
      sc[i] = v / (1.f + expf(-v));
    }
    __syncthreads();
    float* mod = ws_f(p, OFF_MOD);
    for (int u = bid; u < 384; u += nb) {
      const int l = u / 192, grp = u % 192, nn = tid & 31, kq = tid >> 5, n = grp * 32 + nn;
      const float* w = p.w_ada + ((size_t)l * 1024 + kq * 128) * 6144 + n;
      float s0 = 0, s1 = 0, s2 = 0, s3 = 0, s4 = 0;
#pragma unroll 16
      for (int k = 0; k < 128; ++k) {
        const float wv = w[(size_t)k * 6144];
        const int kk = kq * 128 + k;
        s0 += sc[kk] * wv; s1 += sc[1024 + kk] * wv; s2 += sc[2048 + kk] * wv; s3 += sc[3072 + kk] * wv; s4 += sc[4096 + kk] * wv;
      }
      red[(kq * 5 + 0) * 32 + nn] = s0; red[(kq * 5 + 1) * 32 + nn] = s1; red[(kq * 5 + 2) * 32 + nn] = s2;
      red[(kq * 5 + 3) * 32 + nn] = s3; red[(kq * 5 + 4) * 32 + nn] = s4;
      __syncthreads();
      if (tid < 160) {
        const int j = tid >> 5, c = tid & 31;
        float acc = p.b_ada[l * 6144 + grp * 32 + c];
#pragma unroll
        for (int q = 0; q < 8; ++q) acc += red[(q * 5 + j) * 32 + c];
        mod[(size_t)(l * 5 + j) * 6144 + grp * 32 + c] = acc;
      }
      __syncthreads();
    }
  }
  if (bid == nb - 1) {
    float2* t32 = (float2*)(p.ws + OFF_T32);
    float2* t64 = (float2*)(p.ws + OFF_T64);
    for (int i = tid; i < 512; i += NTHREADS) { const int pos = i >> 3, f = i & 7; const float inv = powf(10000.f, -(float)f / 8.f); const float a = (float)pos * inv; t32[i] = make_float2(cosf(a), sinf(a)); }
    for (int i = tid; i < 1024; i += NTHREADS) { const int pos = i >> 4, f = i & 15; const float inv = powf(10000.f, -(float)f / 16.f); const float a = (float)pos * inv; t64[i] = make_float2(cosf(a), sinf(a)); }
    if (tid < 8) {
      const int l = tid >> 2, h = tid & 3;
      float a = 0, b2 = 0;
      for (int e = 0; e < 32; ++e) { a += p.lam_q1[(l * 4 + h) * 32 + e] * p.lam_k1[(l * 4 + h) * 32 + e]; b2 += p.lam_q2[(l * 4 + h) * 32 + e] * p.lam_k2[(l * 4 + h) * 32 + e]; }
      ws_f(p, OFF_LAM)[tid] = expf(a) - expf(b2) + lam_init_of(l);
    }
  }
  __syncthreads();
  convert_weights(p, 0, bid, nb, smem);
}

DI void store_h4(bf16_t* dst, float a, float b, float c, float d) { uint2 o; o.x = pack2(a, b); o.y = pack2(c, d); *(uint2*)dst = o; }

DI void phase_modulate0(const Params& p, int bid, int nb) {
  const int lane = threadIdx.x & 63, wave = threadIdx.x >> 6;
  bf16_t* H = ws_b(p, OFF_H);
  const float* mod = ws_f(p, OFF_MOD);
  for (int row = bid * 4 + wave; row < MROWS; row += nb * 4) {
    const int b = row / TT, t = row % TT;
    const float* src = xsrc_row(p, 0, b, t);
    const float* m = mod + (size_t)(0 * 5 + (t < SEQ ? b : 4)) * 6144;
#pragma unroll
    for (int i = 0; i < 4; ++i) {
      const int c = (i * 64 + lane) * 4;
      const float4 x = *(const float4*)(src + c);
      const float4 sh = *(const float4*)(m + c);
      const float4 s = *(const float4*)(m + 1024 + c);
      store_h4(H + (size_t)row * D + c, x.x * (1.f + s.x) + sh.x, x.y * (1.f + s.y) + sh.y, x.z * (1.f + s.z) + sh.z, x.w * (1.f + s.w) + sh.w);
    }
  }
}

constexpr int LROW = 64;
constexpr int LTILE = 128 * LROW;
#define WAIT_V0() asm volatile("s_waitcnt vmcnt(0)" ::: "memory")
#define GLDS16(gp, lp) __builtin_amdgcn_global_load_lds((const unsigned*)(gp), (unsigned*)(lp), 16, 0, 0)
#define STAGE_A(buf, kt) { _Pragma("unroll") for (int i = 0; i < 4; ++i) GLDS16(ga + (size_t)(32 * i) * lda + (kt) * 64, sA + (buf) * LTILE + (i * 32 + wave * 8) * LROW); }
#define STAGE_B(buf, kt, NI) { _Pragma("unroll") for (int i = 0; i < (NI); ++i) GLDS16(gb + (size_t)(32 * i) * ldb + (kt) * 64, sB + (buf) * LTILE + (i * 32 + wave * 8) * LROW); }
#define CORE_SETUP() \
  const int tid = opaque(threadIdx.x), lane = tid & 63, wave = tid >> 6; \
  const int wm = wave >> 1, wn = wave & 1; \
  const int srow = tid >> 3, skc = (tid & 7) ^ ((srow >> 1) & 7); \
  const bf16_t* ga = A + (size_t)srow * lda + skc * 8; \
  const bf16_t* gb = B + (size_t)srow * ldb + skc * 8; \
  const int l31 = lane & 31, fh = lane >> 5, fsw = (lane >> 1) & 7; \
  const int c0 = ((0 + fh) ^ fsw) * 8, c1 = ((2 + fh) ^ fsw) * 8, c2 = ((4 + fh) ^ fsw) * 8, c3 = ((6 + fh) ^ fsw) * 8;

#define LDSA(p) ((unsigned)(size_t)(p))
DI void lds_read16(bf16x8& a00, bf16x8& a01, bf16x8& b00, bf16x8& b01, bf16x8& a10, bf16x8& a11, bf16x8& b10, bf16x8& b11,
                   bf16x8& a20, bf16x8& a21, bf16x8& b20, bf16x8& b21, bf16x8& a30, bf16x8& a31, bf16x8& b30, bf16x8& b31,
                   unsigned pa0, unsigned pa1, unsigned pa2, unsigned pa3, unsigned pb0, unsigned pb1, unsigned pb2, unsigned pb3) {
  asm volatile(
      "ds_read_b128 %0, %16\n\tds_read_b128 %1, %16 offset:4096\n\tds_read_b128 %2, %20\n\tds_read_b128 %3, %20 offset:4096\n\t"
      "ds_read_b128 %4, %17\n\tds_read_b128 %5, %17 offset:4096\n\tds_read_b128 %6, %21\n\tds_read_b128 %7, %21 offset:4096\n\t"
      "ds_read_b128 %8, %18\n\tds_read_b128 %9, %18 offset:4096\n\tds_read_b128 %10, %22\n\tds_read_b128 %11, %22 offset:4096\n\t"
      "ds_read_b128 %12, %19\n\tds_read_b128 %13, %19 offset:4096\n\tds_read_b128 %14, %23\n\tds_read_b128 %15, %23 offset:4096"
      : "=&v"(a00), "=&v"(a01), "=&v"(b00), "=&v"(b01), "=&v"(a10), "=&v"(a11), "=&v"(b10), "=&v"(b11),
        "=&v"(a20), "=&v"(a21), "=&v"(b20), "=&v"(b21), "=&v"(a30), "=&v"(a31), "=&v"(b30), "=&v"(b31)
      : "v"(pa0), "v"(pa1), "v"(pa2), "v"(pa3), "v"(pb0), "v"(pb1), "v"(pb2), "v"(pb3)
      : "memory");
}
#define LGKM_WAIT4(n, x0, x1, x2, x3) asm volatile("s_waitcnt lgkmcnt(" #n ")" : "+v"(x0), "+v"(x1), "+v"(x2), "+v"(x3))
DI void lds_read4(bf16x8& a0, bf16x8& a1, bf16x8& b0, bf16x8& b1, unsigned pa, unsigned pb) {
  asm volatile("ds_read_b128 %0, %4\n\tds_read_b128 %1, %4 offset:4096\n\tds_read_b128 %2, %5\n\tds_read_b128 %3, %5 offset:4096\n\ts_waitcnt lgkmcnt(0)"
               : "=&v"(a0), "=&v"(a1), "=&v"(b0), "=&v"(b1) : "v"(pa), "v"(pb) : "memory");
}
DI void lds_read3(bf16x8& a0, bf16x8& a1, bf16x8& b0, unsigned pa, unsigned pb) {
  asm volatile("ds_read_b128 %0, %3\n\tds_read_b128 %1, %3 offset:4096\n\tds_read_b128 %2, %4\n\ts_waitcnt lgkmcnt(0)"
               : "=&v"(a0), "=&v"(a1), "=&v"(b0) : "v"(pa), "v"(pb) : "memory");
}

DI void gemm_accum(f32x16 (&acc)[2][2], const bf16_t* __restrict__ A, int lda, const bf16_t* __restrict__ B, int ldb, int nk, bf16_t* sA, bf16_t* sB) {
  CORE_SETUP()
  STAGE_A(0, 0) STAGE_B(0, 0, 4)
  WAIT_V0(); __syncthreads();
  const unsigned la = LDSA(sA) + (wm * 64 + l31) * (LROW * 2), lb = LDSA(sB) + (wn * 64 + l31) * (LROW * 2);
#pragma unroll 1
  for (int kt = 0; kt < nk; ++kt) {
    const int cur = kt & 1;
    if (kt + 1 < nk) { STAGE_A(cur ^ 1, kt + 1) STAGE_B(cur ^ 1, kt + 1, 4) }
    const unsigned pa = la + cur * (LTILE * 2), pb = lb + cur * (LTILE * 2);
    bf16x8 a00, a01, b00, b01, a10, a11, b10, b11, a20, a21, b20, b21, a30, a31, b30, b31;
    lds_read16(a00, a01, b00, b01, a10, a11, b10, b11, a20, a21, b20, b21, a30, a31, b30, b31,
               pa + c0 * 2, pa + c1 * 2, pa + c2 * 2, pa + c3 * 2, pb + c0 * 2, pb + c1 * 2, pb + c2 * 2, pb + c3 * 2);
    LGKM_WAIT4(12, a00, a01, b00, b01);
    __builtin_amdgcn_s_setprio(1);
    acc[0][0] = MFMA32(a00, b00, acc[0][0]); acc[0][1] = MFMA32(a00, b01, acc[0][1]); acc[1][0] = MFMA32(a01, b00, acc[1][0]); acc[1][1] = MFMA32(a01, b01, acc[1][1]);
    __builtin_amdgcn_sched_barrier(0);
    LGKM_WAIT4(8, a10, a11, b10, b11);
    acc[0][0] = MFMA32(a10, b10, acc[0][0]); acc[0][1] = MFMA32(a10, b11, acc[0][1]); acc[1][0] = MFMA32(a11, b10, acc[1][0]); acc[1][1] = MFMA32(a11, b11, acc[1][1]);
    __builtin_amdgcn_sched_barrier(0);
    LGKM_WAIT4(4, a20, a21, b20, b21);
    acc[0][0] = MFMA32(a20, b20, acc[0][0]); acc[0][1] = MFMA32(a20, b21, acc[0][1]); acc[1][0] = MFMA32(a21, b20, acc[1][0]); acc[1][1] = MFMA32(a21, b21, acc[1][1]);
    __builtin_amdgcn_sched_barrier(0);
    LGKM_WAIT4(0, a30, a31, b30, b31);
    acc[0][0] = MFMA32(a30, b30, acc[0][0]); acc[0][1] = MFMA32(a30, b31, acc[0][1]); acc[1][0] = MFMA32(a31, b30, acc[1][0]); acc[1][1] = MFMA32(a31, b31, acc[1][1]);
    __builtin_amdgcn_s_setprio(0);
    __builtin_amdgcn_sched_barrier(0);
    WAIT_V0(); __syncthreads();
  }
}
DI void lds_read8(bf16x8& a00, bf16x8& a01, bf16x8& b00, bf16x8& b01, bf16x8& a10, bf16x8& a11, bf16x8& b10, bf16x8& b11,
                  unsigned pa0, unsigned pa1, unsigned pb0, unsigned pb1) {
  asm volatile(
      "ds_read_b128 %0, %8\n\tds_read_b128 %1, %8 offset:4096\n\tds_read_b128 %2, %10\n\tds_read_b128 %3, %10 offset:4096\n\t"
      "ds_read_b128 %4, %9\n\tds_read_b128 %5, %9 offset:4096\n\tds_read_b128 %6, %11\n\tds_read_b128 %7, %11 offset:4096"
      : "=&v"(a00), "=&v"(a01), "=&v"(b00), "=&v"(b01), "=&v"(a10), "=&v"(a11), "=&v"(b10), "=&v"(b11)
      : "v"(pa0), "v"(pa1), "v"(pb0), "v"(pb1) : "memory");
}
DI void gemm_accum_lite(f32x16 (&acc)[2][2], const bf16_t* __restrict__ A, int lda, const bf16_t* __restrict__ B, int ldb, int nk, bf16_t* sA, bf16_t* sB) {
  CORE_SETUP()
  STAGE_A(0, 0) STAGE_B(0, 0, 4)
  WAIT_V0(); __syncthreads();
  const unsigned la = LDSA(sA) + (wm * 64 + l31) * (LROW * 2), lb = LDSA(sB) + (wn * 64 + l31) * (LROW * 2);
#pragma unroll 1
  for (int kt = 0; kt < nk; ++kt) {
    const int cur = kt & 1;
    if (kt + 1 < nk) { STAGE_A(cur ^ 1, kt + 1) STAGE_B(cur ^ 1, kt + 1, 4) }
    const unsigned pa = la + cur * (LTILE * 2), pb = lb + cur * (LTILE * 2);
#pragma unroll
    for (int g = 0; g < 2; ++g) {
      const int ca = g ? c2 : c0, cb = g ? c3 : c1;
      bf16x8 a00, a01, b00, b01, a10, a11, b10, b11;
      lds_read8(a00, a01, b00, b01, a10, a11, b10, b11, pa + ca * 2, pa + cb * 2, pb + ca * 2, pb + cb * 2);
      LGKM_WAIT4(4, a00, a01, b00, b01);
      __builtin_amdgcn_s_setprio(1);
      acc[0][0] = MFMA32(a00, b00, acc[0][0]); acc[0][1] = MFMA32(a00, b01, acc[0][1]); acc[1][0] = MFMA32(a01, b00, acc[1][0]); acc[1][1] = MFMA32(a01, b01, acc[1][1]);
      __builtin_amdgcn_sched_barrier(0);
      LGKM_WAIT4(0, a10, a11, b10, b11);
      acc[0][0] = MFMA32(a10, b10, acc[0][0]); acc[0][1] = MFMA32(a10, b11, acc[0][1]); acc[1][0] = MFMA32(a11, b10, acc[1][0]); acc[1][1] = MFMA32(a11, b11, acc[1][1]);
      __builtin_amdgcn_s_setprio(0);
      __builtin_amdgcn_sched_barrier(0);
    }
    WAIT_V0(); __syncthreads();
  }
}
DI void zero_acc(f32x16 (&acc)[2][2]) {
#pragma unroll
  for (int a = 0; a < 2; ++a)
#pragma unroll
    for (int b = 0; b < 2; ++b)
#pragma unroll
      for (int i = 0; i < 16; ++i) acc[a][b][i] = 0.f;
}

DI void gemm_accum_n64(f32x16 (&acc)[2], const bf16_t* __restrict__ A, int lda, const bf16_t* __restrict__ B, int ldb, int nk, bf16_t* sA, bf16_t* sB) {
  CORE_SETUP()
  STAGE_A(0, 0) STAGE_B(0, 0, 2)
  WAIT_V0(); __syncthreads();
  const unsigned la = LDSA(sA) + (wm * 64 + l31) * (LROW * 2), lb = LDSA(sB) + (wn * 32 + l31) * (LROW * 2);
#pragma unroll 1
  for (int kt = 0; kt < nk; ++kt) {
    const int cur = kt & 1;
    if (kt + 1 < nk) { STAGE_A(cur ^ 1, kt + 1) STAGE_B(cur ^ 1, kt + 1, 2) }
    const unsigned pa = la + cur * (LTILE * 2), pb = lb + cur * (LTILE * 2);
#pragma unroll
    for (int kk = 0; kk < 4; ++kk) {
      const int ck = (kk == 0) ? c0 : (kk == 1) ? c1 : (kk == 2) ? c2 : c3;
      bf16x8 a0, a1, b0;
      lds_read3(a0, a1, b0, pa + ck * 2, pb + ck * 2);
      acc[0] = MFMA32(a0, b0, acc[0]); acc[1] = MFMA32(a1, b0, acc[1]);
      __builtin_amdgcn_sched_barrier(0);
    }
    WAIT_V0(); __syncthreads();
  }
}

constexpr int WA_STG = 128 * 32, WB_STG = 256 * 32;
#define WSTAGE_A(s, kt) { _Pragma("unroll") for (int i = 0; i < 2; ++i) GLDS16(ga + (size_t)(64 * i) * lda + (kt) * 32, sA + (s) * WA_STG + (i * 64 + wave * 16) * 32); }
#define WSTAGE_B(s, kt) { _Pragma("unroll") for (int i = 0; i < 4; ++i) GLDS16(gb + (size_t)(64 * i) * ldb + (kt) * 32, sB + (s) * WB_STG + (i * 64 + wave * 16) * 32); }
#define LGKM_WAIT6(n, x0, x1, x2, x3, x4, x5) asm volatile("s_waitcnt lgkmcnt(" #n ")" : "+v"(x0), "+v"(x1), "+v"(x2), "+v"(x3), "+v"(x4), "+v"(x5))
DI void lds_read12(bf16x8& a00, bf16x8& a01, bf16x8& b00, bf16x8& b01, bf16x8& b02, bf16x8& b03,
                   bf16x8& a10, bf16x8& a11, bf16x8& b10, bf16x8& b11, bf16x8& b12, bf16x8& b13,
                   unsigned pa0, unsigned pa1, unsigned pb0, unsigned pb1) {
  asm volatile(
      "ds_read_b128 %0, %12\n\tds_read_b128 %1, %12 offset:2048\n\t"
      "ds_read_b128 %2, %14\n\tds_read_b128 %3, %14 offset:2048\n\tds_read_b128 %4, %14 offset:4096\n\tds_read_b128 %5, %14 offset:6144\n\t"
      "ds_read_b128 %6, %13\n\tds_read_b128 %7, %13 offset:2048\n\t"
      "ds_read_b128 %8, %15\n\tds_read_b128 %9, %15 offset:2048\n\tds_read_b128 %10, %15 offset:4096\n\tds_read_b128 %11, %15 offset:6144"
      : "=&v"(a00), "=&v"(a01), "=&v"(b00), "=&v"(b01), "=&v"(b02), "=&v"(b03),
        "=&v"(a10), "=&v"(a11), "=&v"(b10), "=&v"(b11), "=&v"(b12), "=&v"(b13)
      : "v"(pa0), "v"(pa1), "v"(pb0), "v"(pb1) : "memory");
}
DI void gemm_accum_wide(f32x16 (&acc)[2][4], const bf16_t* __restrict__ A, int lda, const bf16_t* __restrict__ B, int ldb, int nk32, bf16_t* sA, bf16_t* sB) {
  const int tid = opaque(threadIdx.x), lane = tid & 63, wave = tid >> 6;
  const int wm = wave >> 1, wn = wave & 1;
  const int srow = tid >> 2, skc = (tid & 3) ^ ((srow >> 2) & 3);
  const bf16_t* ga = A + (size_t)srow * lda + skc * 8;
  const bf16_t* gb = B + (size_t)srow * ldb + skc * 8;
  const int l31 = lane & 31, fh = lane >> 5, fsw = (lane >> 2) & 3;
  const unsigned c0 = (unsigned)((fh ^ fsw) * 16), c1 = (unsigned)(((2 + fh) ^ fsw) * 16);
  const unsigned la = LDSA(sA) + (wm * 64 + l31) * 64, lb = LDSA(sB) + (wn * 128 + l31) * 64;
  WSTAGE_A(0, 0) WSTAGE_B(0, 0)
  WAIT_V0(); __syncthreads();
#pragma unroll 1
  for (int kt = 0; kt < nk32; ++kt) {
    const int cur = kt & 1;
    if (kt + 1 < nk32) { WSTAGE_A(cur ^ 1, kt + 1) WSTAGE_B(cur ^ 1, kt + 1) }
    const unsigned pa = la + cur * (WA_STG * 2), pb = lb + cur * (WB_STG * 2);
    bf16x8 a00, a01, b00, b01, b02, b03, a10, a11, b10, b11, b12, b13;
    lds_read12(a00, a01, b00, b01, b02, b03, a10, a11, b10, b11, b12, b13, pa + c0, pa + c1, pb + c0, pb + c1);
    LGKM_WAIT6(6, a00, a01, b00, b01, b02, b03);
    __builtin_amdgcn_s_setprio(1);
    acc[0][0] = MFMA32(a00, b00, acc[0][0]); acc[0][1] = MFMA32(a00, b01, acc[0][1]); acc[0][2] = MFMA32(a00, b02, acc[0][2]); acc[0][3] = MFMA32(a00, b03, acc[0][3]);
    acc[1][0] = MFMA32(a01, b00, acc[1][0]); acc[1][1] = MFMA32(a01, b01, acc[1][1]); acc[1][2] = MFMA32(a01, b02, acc[1][2]); acc[1][3] = MFMA32(a01, b03, acc[1][3]);
    __builtin_amdgcn_sched_barrier(0);
    LGKM_WAIT6(0, a10, a11, b10, b11, b12, b13);
    acc[0][0] = MFMA32(a10, b10, acc[0][0]); acc[0][1] = MFMA32(a10, b11, acc[0][1]); acc[0][2] = MFMA32(a10, b12, acc[0][2]); acc[0][3] = MFMA32(a10, b13, acc[0][3]);
    acc[1][0] = MFMA32(a11, b10, acc[1][0]); acc[1][1] = MFMA32(a11, b11, acc[1][1]); acc[1][2] = MFMA32(a11, b12, acc[1][2]); acc[1][3] = MFMA32(a11, b13, acc[1][3]);
    __builtin_amdgcn_s_setprio(0);
    __builtin_amdgcn_sched_barrier(0);
    WAIT_V0(); __syncthreads();
  }
}

DI void decode_tile(int idx, int xcd, int nmt, int NT, int& mt_lin, int& nt) {
  const int MB = nmt >> 3;
  if (idx < 8 * NT) { nt = idx >> 3; mt_lin = xcd * MB + (idx & 7); }
  else { const int i2 = idx - 8 * NT, gsz = MB - 8; nt = i2 / gsz; mt_lin = xcd * MB + 8 + i2 % gsz; }
}
DI int map_mtile(int mt, bool latent_only) { return latent_only ? (mt >> 5) * 34 + (mt & 31) : mt; }

DI void store_hm(bf16_t* base, int nh, int hd, int b, int t0, int cs, int h, const f32x16& a) {
  const int hh = cs / hd, d = cs % hd;
  bf16_t* dst = base + ((size_t)(b * nh + hh) * TT + t0) * hd + d;
#pragma unroll
  for (int r = 0; r < 16; ++r) dst[(size_t)crow(r, h) * hd] = f2bf(a[r]);
}
DI void store_tr(bf16_t* base, int nh, int b, int t0, int cs, int h, const f32x16& a) {
  const int hh = cs >> 6, d = cs & 63;
  bf16_t* dst = base + ((size_t)(b * nh + hh) * 64 + d) * TT + t0 + 4 * h;
#pragma unroll
  for (int g = 0; g < 4; ++g) { uint2 o; o.x = pack2(a[4 * g], a[4 * g + 1]); o.y = pack2(a[4 * g + 2], a[4 * g + 3]); *(uint2*)(dst + 8 * g) = o; }
}

DI void phase_gemm1(const Params& p, int bid, int nb, char* smem) {
  bf16_t* sA = (bf16_t*)smem; bf16_t* sB = sA + 2 * WA_STG;
  const bf16_t* H = ws_b(p, OFF_H);
  bf16_t* R = ws_b(p, OFF_S1);
  for (int idx = bid >> 3; idx < 17 * 11; idx += nb >> 3) {
    int mt, nt; decode_tile(idx, bid & 7, 136, 11, mt, nt);
    f32x16 acc[2][4];
#pragma unroll
    for (int a = 0; a < 2; ++a)
#pragma unroll
      for (int c = 0; c < 4; ++c)
#pragma unroll
        for (int r = 0; r < 16; ++r) acc[a][c][r] = 0.f;
    gemm_accum_wide(acc, H + (size_t)mt * 128 * D, D, wb(p, W_IN) + (size_t)nt * 256 * 1024, 1024, 32, sA, sB);
    const int t2 = opaque(threadIdx.x), wm = t2 >> 7, wn = (t2 >> 6) & 1, hq = (t2 >> 5) & 1, lq = t2 & 31;
#pragma unroll
    for (int mi = 0; mi < 2; ++mi)
#pragma unroll
      for (int ni = 0; ni < 4; ++ni) {
        const int row0 = mt * 128 + wm * 64 + mi * 32, c0 = nt * 256 + wn * 128 + ni * 32;
        if (c0 >= NPROJ) continue;
        const int b = row0 / TT, t0 = row0 % TT, col = c0 + lq;
        const f32x16& a = acc[mi][ni];
        if (c0 < RW) {
          bf16_t* dst = R + (size_t)row0 * RW + col;
#pragma unroll
          for (int r = 0; r < 16; ++r) dst[(size_t)crow(r, hq) * RW] = f2bf(a[r]);
        } else {
          const int cc = col - RW, seg = (c0 - RW) >> 8, cs = cc & 255;
          if (seg == 0) store_hm(qkv(p, Q_B), 4, 64, b, t0, cs, hq, a);
          else if (seg == 1) store_hm(qkv(p, K_B), 4, 64, b, t0, cs, hq, a);
          else if (seg == 2) store_tr(qkv(p, V_B), 4, b, t0, cs, hq, a);
          else if (seg == 3) store_hm(qkv(p, Q_C), 8, 32, b, t0, cs, hq, a);
          else if (seg == 4) store_hm(qkv(p, K_C), 8, 32, b, t0, cs, hq, a);
          else if (seg == 5) store_tr(qkv(p, V_C), 4, b, t0, cs, hq, a);
          else if (seg == 6) store_hm(qkv(p, Q_D), 4, 64, b, t0, cs, hq, a);
          else { if (cs < 128) store_hm(qkv(p, K_D), 2, 64, b, t0, cs, hq, a); else store_tr(qkv(p, V_D), 2, b, t0, cs - 128, hq, a); }
        }
      }
  }
}

DI void phase_rowwise(const Params& p, int l, int bid, int nb) {
  const int lane = threadIdx.x & 63, wave = threadIdx.x >> 6;
  bf16_t* R = ws_b(p, OFF_S1);
  float gq[6], gkv[4];
#pragma unroll
  for (int i = 0; i < 6; ++i) gq[i] = p.g_q_a[l * 384 + lane + 64 * i];
#pragma unroll
  for (int i = 0; i < 4; ++i) gkv[i] = p.g_kv_a[l * 256 + lane + 64 * i];
  for (int row = bid * 4 + wave; row < MROWS; row += nb * 4) {
    bf16_t* rr = R + (size_t)row * RW;
    bf16_t lcq[6], lckv[4];
#pragma unroll
    for (int i = 0; i < 6; ++i) lcq[i] = rr[lane + 64 * i];
#pragma unroll
    for (int i = 0; i < 4; ++i) lckv[i] = rr[384 + lane + 64 * i];
    {
      float x[6], ss = 0.f;
#pragma unroll
      for (int i = 0; i < 6; ++i) { x[i] = bf2f(lcq[i]); ss += x[i] * x[i]; }
      ss = wave_sum(ss);
      const float sc = rsqrtf(ss * (1.f / 384.f) + EPS);
#pragma unroll
      for (int i = 0; i < 6; ++i) rr[lane + 64 * i] = f2bf(x[i] * sc * gq[i]);
    }
    {
      float x[4], ss = 0.f;
#pragma unroll
      for (int i = 0; i < 4; ++i) { x[i] = bf2f(lckv[i]); ss += x[i] * x[i]; }
      ss = wave_sum(ss);
      const float sc = rsqrtf(ss * (1.f / 256.f) + EPS);
#pragma unroll
      for (int i = 0; i < 4; ++i) rr[384 + lane + 64 * i] = f2bf(x[i] * sc * gkv[i]);
    }
  }
}
DI void phase_rowwise_b(const Params& p, int l, int bid, int nb) {
  const int lane = threadIdx.x & 63, wave = threadIdx.x >> 6;
  const bf16_t* R = ws_b(p, OFF_S1);
  const float2* t32 = (const float2*)(p.ws + OFF_T32);
  const float2* t64 = (const float2*)(p.ws + OFF_T64);
  const int e = lane & 31;
  const int ax32 = e >> 4, hf32 = (e >> 3) & 1, f32i = e & 7;
  const int ax = lane >> 5, hf = (lane >> 4) & 1, f = lane & 15;
  const float gqn = p.g_qn[l * 64 + lane], gkn = p.g_kn[l * 64 + lane];
  for (int row = bid * 4 + wave; row < MROWS; row += nb * 4) {
    const int b = row / TT, t = row % TT;
    const bool latent = t < SEQ;
    const int pr = (t >> 6) & 63, pc = t & 63;
    bf16_t lq[4], lk[4], lg[6];
    const bf16_t lkpe = R[(size_t)row * RW + 640 + e];
    bf16_t* qptr[4]; bf16_t* kptr[4]; bf16_t* gptr[6];
#pragma unroll
    for (int it = 0; it < 4; ++it) {
      const int m = it * 2 + (lane >> 5);
      qptr[it] = qkv(p, Q_C) + ((size_t)(b * 8 + m) * TT + t) * 32 + e;
      kptr[it] = qkv(p, K_C) + ((size_t)(b * 8 + m) * TT + t) * 32 + e;
      lq[it] = latent ? *qptr[it] : (bf16_t)0; lk[it] = latent ? *kptr[it] : (bf16_t)0;
    }
#pragma unroll
    for (int hh = 0; hh < 6; ++hh) {
      gptr[hh] = (hh < 4) ? qkv(p, Q_D) + ((size_t)(b * 4 + hh) * TT + t) * 64 + lane
                          : qkv(p, K_D) + ((size_t)(b * 2 + (hh - 4)) * TT + t) * 64 + lane;
      lg[hh] = *gptr[hh];
    }
    const float2 cs32 = t32[(ax32 ? pc : pr) * 8 + f32i];
    const float2 cs = t64[(ax ? pc : pr) * 16 + f];
    {
      float x = bf2f(lkpe);
      const float pt = __shfl_xor(x, 8);
      if (latent) x = hf32 ? (pt * cs32.y + x * cs32.x) : (x * cs32.x - pt * cs32.y);
      if (lane < 32) {
        const bf16_t o = f2bf(x);
#pragma unroll
        for (int hh = 0; hh < 4; ++hh) qkv(p, K_A)[((size_t)(b * 4 + hh) * TT + t) * 96 + 64 + e] = o;
      }
    }
    if (latent) {
#pragma unroll
      for (int it = 0; it < 4; ++it) {
        const float xq = bf2f(lq[it]), xk = bf2f(lk[it]);
        const float pq = __shfl_xor(xq, 8), pk = __shfl_xor(xk, 8);
        *qptr[it] = f2bf(hf32 ? (pq * cs32.y + xq * cs32.x) : (xq * cs32.x - pq * cs32.y));
        *kptr[it] = f2bf(hf32 ? (pk * cs32.y + xk * cs32.x) : (xk * cs32.x - pk * cs32.y));
      }
    }
    {
#pragma unroll
      for (int hh = 0; hh < 6; ++hh) {
        const float g = (hh < 4) ? gqn : gkn;
        float x = bf2f(lg[hh]);
        const float ss = wave_sum(x * x);
        x = x * rsqrtf(ss * (1.f / 64.f) + EPS) * g;
        const float pt = __shfl_xor(x, 16);
        if (latent) x = hf ? (pt * cs.y + x * cs.x) : (x * cs.x - pt * cs.y);
        *gptr[hh] = f2bf(x);
      }
    }
  }
}

DI void phase_gemm2(const Params& p, int bid, int nb, char* smem) {
  bf16_t* sA = (bf16_t*)smem; bf16_t* sB = sA + 2 * LTILE;
  const int lane = threadIdx.x & 63, wave = threadIdx.x >> 6, wm = wave >> 1, wn = wave & 1, h = lane >> 5;
  const bf16_t* R = ws_b(p, OFF_S1);
  const float2* t32 = (const float2*)(p.ws + OFF_T32);
  for (int idx = bid >> 3; idx < 17 * 7; idx += nb >> 3) {
    int mt, nt; decode_tile(idx, bid & 7, 136, 7, mt, nt);
    f32x16 acc[2][2]; zero_acc(acc);
    if (nt < 3) gemm_accum(acc, R + (size_t)mt * 128 * RW, RW, wb(p, W_QUP) + (size_t)nt * 128 * 384, 384, 6, sA, sB);
    else gemm_accum(acc, R + (size_t)mt * 128 * RW + 384, RW, wb(p, W_KVUP) + (size_t)(nt - 3) * 128 * 256, 256, 4, sA, sB);
    const int hq = opaque(h), lq = opaque(lane & 31);
#pragma unroll
    for (int mi = 0; mi < 2; ++mi)
#pragma unroll
      for (int ni = 0; ni < 2; ++ni) {
        const int row0 = mt * 128 + wm * 64 + mi * 32;
        const int b = row0 / TT, t0 = row0 % TT;
        const f32x16& a = acc[mi][ni];
        if (nt < 3) {
          const int c0 = nt * 128 + wn * 64 + ni * 32;
          const int hh = c0 / 96, d0 = c0 % 96, e = lq;
          bf16_t* dst = qkv(p, Q_A) + ((size_t)(b * 4 + hh) * TT + t0) * 96 + d0 + e;
          if (d0 == 64 && t0 < SEQ) {
            const int ax = e >> 4, hf = (e >> 3) & 1, f = e & 7;
#pragma unroll
            for (int r = 0; r < 16; ++r) {
              const int t = t0 + crow(r, hq);
              const int pos = ax ? (t & 63) : (t >> 6);
              const float2 cs = t32[pos * 8 + f];
              const float x = a[r], pt = __shfl_xor(x, 8);
              dst[(size_t)crow(r, hq) * 96] = f2bf(hf ? (pt * cs.y + x * cs.x) : (x * cs.x - pt * cs.y));
            }
          } else {
#pragma unroll
            for (int r = 0; r < 16; ++r) dst[(size_t)crow(r, hq) * 96] = f2bf(a[r]);
          }
        } else {
          const int c0 = (nt - 3) * 128 + wn * 64 + ni * 32;
          const int hh = c0 >> 7, d0 = c0 & 127, e = lq;
          if (d0 < 64) {
            bf16_t* dst = qkv(p, K_A) + ((size_t)(b * 4 + hh) * TT + t0) * 96 + d0 + e;
#pragma unroll
            for (int r = 0; r < 16; ++r) dst[(size_t)crow(r, hq) * 96] = f2bf(a[r]);
          } else {
            store_tr(qkv(p, V_A), 4, b, t0, hh * 64 + (d0 - 64) + e, hq, a);
          }
        }
      }
  }
}

DI float dot8(const float* qv, uint4 kv) {
  return qv[0] * __uint_as_float(kv.x << 16) + qv[1] * __uint_as_float(kv.x & 0xffff0000u)
       + qv[2] * __uint_as_float(kv.y << 16) + qv[3] * __uint_as_float(kv.y & 0xffff0000u)
       + qv[4] * __uint_as_float(kv.z << 16) + qv[5] * __uint_as_float(kv.z & 0xffff0000u)
       + qv[6] * __uint_as_float(kv.w << 16) + qv[7] * __uint_as_float(kv.w & 0xffff0000u);
}
DI void online_key(float s, const bf16_t* vcol, float& m, float& lsum, float (&o)[16]) {
  if (s > m) {
    const float c = __expf(m - s);
    lsum *= c;
#pragma unroll
    for (int d = 0; d < 16; ++d) o[d] *= c;
    m = s;
  }
  const float pr = __expf(s - m);
  lsum += pr;
#pragma unroll
  for (int d = 0; d < 16; ++d) o[d] += pr * bf2f(vcol[(size_t)d * TT]);
}
template <int DQK>
DI void naive_dense(const bf16_t* q, const bf16_t* K, const bf16_t* Vt, int k0, int k1, float scale, float (&o)[16]) {
  float qv[DQK];
#pragma unroll
  for (int d = 0; d < DQK; ++d) qv[d] = bf2f(q[d]) * scale;
  float m = -1e30f, lsum = 0.f;
#pragma unroll
  for (int d = 0; d < 16; ++d) o[d] = 0.f;
  for (int key = k0; key < k1; ++key) {
    const bf16_t* kr = K + (size_t)key * DQK;
    float s = 0.f;
#pragma unroll
    for (int d8 = 0; d8 < DQK / 8; ++d8) s += dot8(qv + d8 * 8, *(const uint4*)(kr + d8 * 8));
    online_key(s, Vt + key, m, lsum, o);
  }
  const float inv = 1.f / lsum;
#pragma unroll
  for (int d = 0; d < 16; ++d) o[d] *= inv;
}
DI void store_y(bf16_t* y, const float (&o)[16]) {
#pragma unroll
  for (int d8 = 0; d8 < 2; ++d8) {
    uint4 v; v.x = pack2(o[d8 * 8], o[d8 * 8 + 1]); v.y = pack2(o[d8 * 8 + 2], o[d8 * 8 + 3]); v.z = pack2(o[d8 * 8 + 4], o[d8 * 8 + 5]); v.w = pack2(o[d8 * 8 + 6], o[d8 * 8 + 7]);
    *(uint4*)(y + d8 * 8) = v;
  }
}

DI void phase_attn_naive(const Params& p, int l, int bid, int nb) {
  const int tid = threadIdx.x;
  bf16_t* Y = ws_b(p, OFF_S0);
  const int nqb = (l == 0) ? 68 : 64;
  const int nitems = 4 * 4 * 4 * nqb;
  for (int it = bid; it < nitems; it += nb) {
    const int var = it / (16 * nqb), rem = it % (16 * nqb), b = rem / (4 * nqb), rem2 = rem % (4 * nqb), hh = rem2 / nqb, qb = rem2 % nqb;
    const int t = qb * 64 + (tid >> 2), dq = tid & 3;
    const bool latent = t < SEQ;
    const int k0 = latent ? 0 : SEQ, k1 = TT;
    bf16_t* y = Y + (size_t)(b * TT + t) * D + var * 256 + hh * 64 + dq * 16;
    float o[16];
    if (var == 0) {
      naive_dense<96>(qkv(p, Q_A) + ((size_t)(b * 4 + hh) * TT + t) * 96, qkv(p, K_A) + (size_t)(b * 4 + hh) * TT * 96,
                      qkv(p, V_A) + ((size_t)(b * 4 + hh) * 64 + dq * 16) * TT, k0, k1, 0.10206207261596577f, o);
    } else if (var == 3) {
      const int hk = hh >> 1;
      naive_dense<64>(qkv(p, Q_D) + ((size_t)(b * 4 + hh) * TT + t) * 64, qkv(p, K_D) + (size_t)(b * 2 + hk) * TT * 64,
                      qkv(p, V_D) + ((size_t)(b * 2 + hk) * 64 + dq * 16) * TT, k0, k1, 0.125f, o);
    } else if (var == 2) {
      float o2[16];
      const bf16_t* Vt = qkv(p, V_C) + ((size_t)(b * 4 + hh) * 64 + dq * 16) * TT;
      naive_dense<32>(qkv(p, Q_C) + ((size_t)(b * 8 + hh * 2) * TT + t) * 32, qkv(p, K_C) + (size_t)(b * 8 + hh * 2) * TT * 32, Vt, k0, k1, 0.17677669529663687f, o);
      naive_dense<32>(qkv(p, Q_C) + ((size_t)(b * 8 + hh * 2 + 1) * TT + t) * 32, qkv(p, K_C) + (size_t)(b * 8 + hh * 2 + 1) * TT * 32, Vt, k0, k1, 0.17677669529663687f, o2);
      const float lam = ws_f(p, OFF_LAM)[l * 4 + hh];
      float ss = 0.f;
#pragma unroll
      for (int d = 0; d < 16; ++d) { o[d] -= lam * o2[d]; ss += o[d] * o[d]; }
      ss += __shfl_xor(ss, 1); ss += __shfl_xor(ss, 2);
      const float sc = rsqrtf(ss * (1.f / 64.f) + EPS) * (1.f - lam_init_of(l));
#pragma unroll
      for (int d = 0; d < 16; ++d) o[d] *= sc * p.g_sub[l * 64 + dq * 16 + d];
    } else {
      const bf16_t* Kb = qkv(p, K_B) + (size_t)(b * 4 + hh) * TT * 64;
      const bf16_t* Vt = qkv(p, V_B) + ((size_t)(b * 4 + hh) * 64 + dq * 16) * TT;
      const bf16_t* q = qkv(p, Q_B) + ((size_t)(b * 4 + hh) * TT + t) * 64;
      if (!latent) {
        naive_dense<64>(q, Kb, Vt, SEQ, TT, 0.125f, o);
      } else {
        float qv[64];
#pragma unroll
        for (int d = 0; d < 64; ++d) qv[d] = bf2f(q[d]) * 0.125f;
        float m = -1e30f, lsum = 0.f;
#pragma unroll
        for (int d = 0; d < 16; ++d) o[d] = 0.f;
        const int r = t >> 6, w = t & 63;
        const int rs = min(max(r - 4, 0), 56), cs = min(max(w - 8, 0), 48);
        const float* rpb = p.rpb + (size_t)(l * 4 + hh) * 15 * 31;
        for (int kk = 0; kk < 384; ++kk) {
          int key; float bias = 0.f;
          if (kk < 128) { const int i = kk >> 4, j = kk & 15; key = (rs + i) * 64 + cs + j; bias = rpb[(rs + i - r + 7) * 31 + (cs + j - w + 15)]; }
          else key = SEQ + (kk - 128);
          const bf16_t* kr = Kb + (size_t)key * 64;
          float s = 0.f;
#pragma unroll
          for (int d8 = 0; d8 < 8; ++d8) s += dot8(qv + d8 * 8, *(const uint4*)(kr + d8 * 8));
          online_key(s + bias, Vt + key, m, lsum, o);
        }
        const float inv = 1.f / lsum;
#pragma unroll
        for (int d = 0; d < 16; ++d) o[d] *= inv;
      }
    }
    store_y(y, o);
  }
}

struct TileMap { int nfirst, first0, second0, ntiles; };
constexpr int ATT_SV_OFF = 26624, ATT_BIAS_OFF = 44032;

template <int DQK, bool NA>
DI void flash_pass(const bf16_t* __restrict__ Qg, const bf16_t* __restrict__ Kg, const bf16_t* __restrict__ Vg,
                   int q0, TileMap tm, float c, f32x16 (&o)[2], char* smem, const float* sBias) {
  constexpr int KR = DQK + 8, KT = 64 * KR, VR = 68, VT = 64 * VR, NKC = DQK / 32, CPR = DQK / 8;
  bf16_t* sK = (bf16_t*)smem;
  bf16_t* sV = (bf16_t*)(smem + ATT_SV_OFF);
  const int tid = opaque(threadIdx.x), lane = tid & 63, wave = tid >> 6, h = lane >> 5, li = lane & 31;
  bf16x8 qf[DQK / 16];
  {
    const bf16_t* qp = Qg + (size_t)(q0 + wave * 32 + li) * DQK + h * 8;
#pragma unroll
    for (int kk = 0; kk < DQK / 16; ++kk) qf[kk] = *(const bf16x8*)(qp + kk * 16);
  }
#pragma unroll
  for (int mb = 0; mb < 2; ++mb)
#pragma unroll
    for (int r = 0; r < 16; ++r) o[mb][r] = 0.f;
  float m = -1e30f, lsum = 0.f;
  const int r_w = (q0 >> 6) + (wave >> 1), rs_w = min(max(r_w - 4, 0), 56);
  const int w_q = (wave & 1) * 32 + li, cs_q = min(max(w_q - 8, 0), 48);
  uint4 rk0, rk1, rk2, rv0, rv1;
  rk1 = make_uint4(0, 0, 0, 0); rk2 = rk1;
#define KEY0_OF(tile) ((tile) < tm.nfirst ? tm.first0 + (tile) * 64 : tm.second0 + ((tile) - tm.nfirst) * 64)
#define GK(i) *(const uint4*)(Kg + (size_t)key0 * DQK + (tid + 256 * (i)) * 8)
#define GV(i) *(const uint4*)(Vg + (size_t)((tid + 256 * (i)) >> 3) * TT + key0 + ((tid + 256 * (i)) & 7) * 8)
#define GLOAD(tile) { const int key0 = KEY0_OF(tile); rk0 = GK(0); if (NKC > 1) rk1 = GK(1); if (NKC > 2) rk2 = GK(2); rv0 = GV(0); rv1 = GV(1); }
#define WK(buf, i, r) { const int id = tid + 256 * (i); const int row = id / CPR, cc = id % CPR; *(uint4*)(sK + (buf) * KT + row * KR + cc * 8) = r; }
#define WV(buf, i, r) { const int id = tid + 256 * (i); bf16_t* d = sV + (buf) * VT + (id >> 3) * VR + (id & 7) * 8; \
      *(uint2*)d = make_uint2(r.x, r.y); *(uint2*)(d + 4) = make_uint2(r.z, r.w); }
#define LWRITE(buf) { WK(buf, 0, rk0) if (NKC > 1) WK(buf, 1, rk1) if (NKC > 2) WK(buf, 2, rk2) WV(buf, 0, rv0) WV(buf, 1, rv1) }
  GLOAD(0)
  LWRITE(0)
#pragma unroll
  for (int kk = 0; kk < DQK / 16; ++kk) asm volatile("" :: "v"(qf[kk]));
  __syncthreads();
#pragma unroll 1
  for (int tile = 0; tile < tm.ntiles; ++tile) {
    const int cur = tile & 1;
    const bool more = tile + 1 < tm.ntiles;
    if (more) GLOAD(tile + 1)
    bool active = true;
    int kr = 0;
    if (NA && tile >= tm.nfirst) { kr = (tm.second0 >> 6) + (tile - tm.nfirst); active = (kr >= rs_w) && (kr < rs_w + 8); }
    if (active) {
      f32x16 s[2];
      bf16x8 kf[2][DQK / 16];
#pragma unroll
      for (int kb = 0; kb < 2; ++kb) {
#pragma unroll
        for (int r = 0; r < 16; ++r) s[kb][r] = 0.f;
        const bf16_t* kp = sK + cur * KT + (kb * 32 + li) * KR + h * 8;
#pragma unroll
        for (int kk = 0; kk < DQK / 16; ++kk) {
          if (NA) s[kb] = MFMA32(*(const bf16x8*)(kp + kk * 16), qf[kk], s[kb]);
          else kf[kb][kk] = *(const bf16x8*)(kp + kk * 16);
        }
      }
      if (!NA) {
        __builtin_amdgcn_sched_barrier(0);
#pragma unroll
        for (int kk = 0; kk < DQK / 16; ++kk) {
          s[0] = MFMA32(kf[0][kk], qf[kk], s[0]);
          s[1] = MFMA32(kf[1][kk], qf[kk], s[1]);
        }
      }
      bf16x8 vf[2][2][2];
      if (!NA) {
#pragma unroll
      for (int kb = 0; kb < 2; ++kb)
#pragma unroll
        for (int s2 = 0; s2 < 2; ++s2)
#pragma unroll
          for (int mb = 0; mb < 2; ++mb) {
            const bf16_t* vp = sV + cur * VT + (mb * 32 + li) * VR + kb * 32 + 16 * s2 + 4 * h;
            const uint2 lo = *(const uint2*)vp, hi = *(const uint2*)(vp + 8);
            uint4 u; u.x = lo.x; u.y = lo.y; u.z = hi.x; u.w = hi.y;
            vf[kb][s2][mb] = __builtin_bit_cast(bf16x8, u);
          }
      __builtin_amdgcn_sched_barrier(0);
      }
      if (NA && tile >= tm.nfirst) {
        const float* brow = sBias + (kr - r_w + 7) * 31;
#pragma unroll
        for (int kb = 0; kb < 2; ++kb)
#pragma unroll
          for (int r = 0; r < 16; ++r) {
            const int cidx = kb * 32 + crow(r, h);
            const bool ok = (unsigned)(cidx - cs_q) < 16u;
            const int bi = min(max(cidx - w_q + 15, 0), 30);
            s[kb][r] = ok ? s[kb][r] + 8.f * brow[bi] : -1e30f;
          }
      }
      float mx = s[0][0];
#pragma unroll
      for (int kb = 0; kb < 2; ++kb)
#pragma unroll
        for (int r = 0; r < 16; ++r) mx = fmaxf(mx, s[kb][r]);
      mx = xhalf_max(mx);
      const float m_new = fmaxf(m, mx);
      if (__any(m_new > m)) {
        const float alpha = __builtin_amdgcn_exp2f((m - m_new) * c);
        lsum *= alpha;
#pragma unroll
        for (int mb = 0; mb < 2; ++mb)
#pragma unroll
          for (int r = 0; r < 16; ++r) o[mb][r] *= alpha;
        m = m_new;
      }
      const float mc = m * c;
      bf16x8 pf[2][2];
#pragma unroll
      for (int kb = 0; kb < 2; ++kb) {
        float pv[16];
#pragma unroll
        for (int r = 0; r < 16; ++r) { pv[r] = __builtin_amdgcn_exp2f(fmaf(s[kb][r], c, -mc)); lsum += pv[r]; }
#pragma unroll
        for (int s2 = 0; s2 < 2; ++s2) {
          uint4 u;
          u.x = pack2(pv[8 * s2 + 0], pv[8 * s2 + 1]); u.y = pack2(pv[8 * s2 + 2], pv[8 * s2 + 3]);
          u.z = pack2(pv[8 * s2 + 4], pv[8 * s2 + 5]); u.w = pack2(pv[8 * s2 + 6], pv[8 * s2 + 7]);
          pf[kb][s2] = __builtin_bit_cast(bf16x8, u);
        }
      }
#pragma unroll
      for (int kb = 0; kb < 2; ++kb)
#pragma unroll
        for (int s2 = 0; s2 < 2; ++s2)
#pragma unroll
          for (int mb = 0; mb < 2; ++mb) {
            if (NA) {
              const bf16_t* vp = sV + cur * VT + (mb * 32 + li) * VR + kb * 32 + 16 * s2 + 4 * h;
              const uint2 lo = *(const uint2*)vp, hi = *(const uint2*)(vp + 8);
              uint4 u; u.x = lo.x; u.y = lo.y; u.z = hi.x; u.w = hi.y;
              vf[kb][s2][mb] = __builtin_bit_cast(bf16x8, u);
            }
            o[mb] = MFMA32(vf[kb][s2][mb], pf[kb][s2], o[mb]);
          }
    }
    if (more) LWRITE(cur ^ 1)
    __syncthreads();
  }
  lsum = xhalf_sum(lsum);
  const float inv = 1.f / lsum;
#pragma unroll
  for (int mb = 0; mb < 2; ++mb)
#pragma unroll
    for (int r = 0; r < 16; ++r) o[mb][r] *= inv;
}

DI void store_o(bf16_t* dst  , const f32x16 (&o)[2], int h) {
#pragma unroll
  for (int mb = 0; mb < 2; ++mb)
#pragma unroll
    for (int g = 0; g < 4; ++g) {
      uint2 v; v.x = pack2(o[mb][4 * g], o[mb][4 * g + 1]); v.y = pack2(o[mb][4 * g + 2], o[mb][4 * g + 3]);
      *(uint2*)(dst + mb * 32 + 8 * g + 4 * h) = v;
    }
}

template <int VAR>
DI void attn_items(const Params& p, int l, int bid, int nb, char* smem) {
  const int tid = threadIdx.x, lane = tid & 63, wave = tid >> 6, h = lane >> 5, li = lane & 31;
  float* sBias = (float*)(smem + ATT_BIAS_OFF);
  bf16_t* Y = ws_b(p, OFF_S0);
  const int nitems = (l == 0) ? 512 + 32 : 512;
  constexpr float LOG2E = 1.4426950408889634f;
  for (int it0 = bid >> 3; it0 < nitems / 8; it0 += nb >> 3) {
    const int it = (it0 < 64) ? (bid & 7) * 64 + it0 : 512 + (bid & 7) * 4 + (it0 - 64);
    int b, hh, q0; bool latent;
    if (it < 512) { b = it >> 7; hh = (it >> 5) & 3; q0 = (it & 31) * 128; latent = true; }
    else { const int r = it - 512; b = (r >> 3) & 3; hh = (r >> 1) & 3; q0 = SEQ + (r & 1) * 128; latent = false; }
    TileMap tm;
    if (latent) { tm.nfirst = 68; tm.first0 = 0; tm.second0 = 0; tm.ntiles = 68; }
    else { tm.nfirst = 4; tm.first0 = SEQ; tm.second0 = 0; tm.ntiles = 4; }
    bf16_t* y = Y + (size_t)(b * TT + q0 + wave * 32 + li) * D + VAR * 256 + hh * 64;
    f32x16 o[2];
    if (VAR == 0) {
      flash_pass<96, false>(qkv(p, Q_A) + (size_t)(b * 4 + hh) * TT * 96, qkv(p, K_A) + (size_t)(b * 4 + hh) * TT * 96,
                            qkv(p, V_A) + (size_t)(b * 4 + hh) * 64 * TT, q0, tm, 0.10206207261596577f * LOG2E, o, smem, sBias);
    } else if (VAR == 3) {
      const int hk = hh >> 1;
      flash_pass<64, false>(qkv(p, Q_D) + (size_t)(b * 4 + hh) * TT * 64, qkv(p, K_D) + (size_t)(b * 2 + hk) * TT * 64,
                            qkv(p, V_D) + (size_t)(b * 2 + hk) * 64 * TT, q0, tm, 0.125f * LOG2E, o, smem, sBias);
    } else if (VAR == 2) {
      f32x16 o2[2];
      const bf16_t* Vt = qkv(p, V_C) + (size_t)(b * 4 + hh) * 64 * TT;
      flash_pass<32, false>(qkv(p, Q_C) + (size_t)(b * 8 + hh * 2) * TT * 32, qkv(p, K_C) + (size_t)(b * 8 + hh * 2) * TT * 32, Vt, q0, tm, 0.17677669529663687f * LOG2E, o, smem, sBias);
      flash_pass<32, false>(qkv(p, Q_C) + (size_t)(b * 8 + hh * 2 + 1) * TT * 32, qkv(p, K_C) + (size_t)(b * 8 + hh * 2 + 1) * TT * 32, Vt, q0, tm, 0.17677669529663687f * LOG2E, o2, smem, sBias);
      const float lam = ws_f(p, OFF_LAM)[l * 4 + hh];
      float ss = 0.f;
#pragma unroll
      for (int mb = 0; mb < 2; ++mb)
#pragma unroll
        for (int r = 0; r < 16; ++r) { const float v = o[mb][r] - lam * o2[mb][r]; o[mb][r] = v; ss += v * v; }
      ss = xhalf_sum(ss);
      const float sc = rsqrtf(ss * (1.f / 64.f) + EPS) * (1.f - lam_init_of(l));
#pragma unroll
      for (int mb = 0; mb < 2; ++mb)
#pragma unroll
        for (int r = 0; r < 16; ++r) o[mb][r] *= sc * p.g_sub[l * 64 + mb * 32 + crow(r, h)];
    } else {
      const bf16_t* Qb = qkv(p, Q_B) + (size_t)(b * 4 + hh) * TT * 64;
      const bf16_t* Kb = qkv(p, K_B) + (size_t)(b * 4 + hh) * TT * 64;
      const bf16_t* Vt = qkv(p, V_B) + (size_t)(b * 4 + hh) * 64 * TT;
      if (latent) {
        for (int i = tid; i < 465; i += NTHREADS) sBias[i] = p.rpb[(size_t)(l * 4 + hh) * 465 + i];
        const int r0 = q0 >> 6;
        const int rs0 = min(max(r0 - 4, 0), 56), rs1 = min(max(r0 + 1 - 4, 0), 56);
        tm.nfirst = 4; tm.first0 = SEQ; tm.second0 = rs0 * 64; tm.ntiles = 4 + (rs1 - rs0) + 8;
        flash_pass<64, true>(Qb, Kb, Vt, q0, tm, 0.125f * LOG2E, o, smem, sBias);
      } else {
        flash_pass<64, false>(Qb, Kb, Vt, q0, tm, 0.125f * LOG2E, o, smem, sBias);
      }
    }
    store_o(y, o, h);
  }
}
DI void phase_attn(const Params& p, int l, int bid, int nb, char* smem) {
  attn_items<2>(p, l, bid, nb, smem);
  attn_items<0>(p, l, bid, nb, smem);
  attn_items<3>(p, l, bid, nb, smem);
  attn_items<1>(p, l, bid, nb, smem);
}

DI void phase_merge(const Params& p, int l, int bid, int nb, char* smem) {
  bf16_t* sA = (bf16_t*)smem; bf16_t* sB = sA + 2 * LTILE;
  const bf16_t* H = ws_b(p, OFF_H);
  const bf16_t* Y = ws_b(p, OFF_S0);
  bf16_t* ACC = ws_b(p, OFF_S1);
  for (int idx = bid >> 3; idx < 16 * 8; idx += nb >> 3) {
    int mtl, nt; decode_tile(idx, bid & 7, 128, 8, mtl, nt);
    const int mt = map_mtile(mtl, true);
    f32x16 acc[2][2]; zero_acc(acc);
#pragma unroll 1
    for (int i = 0; i < 4; ++i) {
      unsigned pp[2][2][8];
      {
        f32x16 ap[2][2]; zero_acc(ap);
        gemm_accum_lite(ap, Y + (size_t)mt * 128 * D + i * 256, D, wb(p, W_BR) + ((size_t)i * 1024 + nt * 128) * 256, 256, 4, sA, sB);
#pragma unroll
        for (int a = 0; a < 2; ++a)
#pragma unroll
          for (int c = 0; c < 2; ++c)
#pragma unroll
            for (int r = 0; r < 8; ++r) pp[a][c][r] = pack2(ap[a][c][2 * r], ap[a][c][2 * r + 1]);
      }
      f32x16 ag[2][2]; zero_acc(ag);
      gemm_accum_lite(ag, H + (size_t)mt * 128 * D, D, wb(p, W_IN) + (size_t)(NPROJ + i * 1024 + nt * 128) * 1024, 1024, 16, sA, sB);
#pragma unroll
      for (int a = 0; a < 2; ++a)
#pragma unroll
        for (int c = 0; c < 2; ++c)
#pragma unroll
          for (int r = 0; r < 8; ++r) {
            acc[a][c][2 * r] += __uint_as_float(pp[a][c][r] << 16) / (1.f + __expf(-ag[a][c][2 * r]));
            acc[a][c][2 * r + 1] += __uint_as_float(pp[a][c][r] & 0xffff0000u) / (1.f + __expf(-ag[a][c][2 * r + 1]));
          }
    }
    const int t2 = opaque(threadIdx.x), wm = t2 >> 7, wn = (t2 >> 6) & 1, hq = (t2 >> 5) & 1, lq = t2 & 31;
#pragma unroll
    for (int mi = 0; mi < 2; ++mi)
#pragma unroll
      for (int ni = 0; ni < 2; ++ni) {
        bf16_t* dst = ACC + (size_t)(mt * 128 + wm * 64 + mi * 32) * D + nt * 128 + wn * 64 + ni * 32 + lq;
#pragma unroll
        for (int r = 0; r < 16; ++r) dst[(size_t)crow(r, hq) * D] = f2bf(acc[mi][ni][r]);
      }
  }
  if (l == 0) {
    for (int u = (nb - 1 - bid); u < 128; u += nb) {
      const int c = u & 7, nt = u >> 3;
      const int mt = (c >> 1) * 34 + 32 + (c & 1);
      f32x16 acc[2];
#pragma unroll
      for (int a = 0; a < 2; ++a)
#pragma unroll
        for (int r = 0; r < 16; ++r) acc[a][r] = 0.f;
#pragma unroll 1
      for (int i = 0; i < 4; ++i) {
        f32x16 ap[2], ag[2];
#pragma unroll
        for (int a = 0; a < 2; ++a)
#pragma unroll
          for (int r = 0; r < 16; ++r) { ap[a][r] = 0.f; ag[a][r] = 0.f; }
        gemm_accum_n64(ap, Y + (size_t)mt * 128 * D + i * 256, D, wb(p, W_BR) + ((size_t)i * 1024 + nt * 64) * 256, 256, 4, sA, sB);
        gemm_accum_n64(ag, H + (size_t)mt * 128 * D, D, wb(p, W_IN) + (size_t)(NPROJ + i * 1024 + nt * 64) * 1024, 1024, 16, sA, sB);
#pragma unroll
        for (int a = 0; a < 2; ++a)
#pragma unroll
          for (int r = 0; r < 16; ++r) acc[a][r] += ap[a][r] / (1.f + __expf(-ag[a][r]));
      }
      const int t2 = opaque(threadIdx.x), wm = t2 >> 7, wn = (t2 >> 6) & 1, hq = (t2 >> 5) & 1, lq = t2 & 31;
#pragma unroll
      for (int mi = 0; mi < 2; ++mi) {
        bf16_t* dst = ACC + (size_t)(mt * 128 + wm * 64 + mi * 32) * D + nt * 64 + wn * 32 + lq;
#pragma unroll
        for (int r = 0; r < 16; ++r) dst[(size_t)crow(r, hq) * D] = f2bf(acc[mi][r]);
      }
    }
  }
}

DI void phase_gemm_plain(const Params& p, int l, int bid, int nb, char* smem, const bf16_t* A, int lda, int nk, const bf16_t* Wt, bf16_t* O) {
  {
    bf16_t* sA = (bf16_t*)smem; bf16_t* sB = sA + 2 * WA_STG;
    for (int idx = bid >> 3; idx < 16 * 4; idx += nb >> 3) {
      int mtl, nt; decode_tile(idx, bid & 7, 128, 4, mtl, nt);
      const int mt = map_mtile(mtl, true);
      f32x16 acc[2][4];
#pragma unroll
      for (int a = 0; a < 2; ++a)
#pragma unroll
        for (int c = 0; c < 4; ++c)
#pragma unroll
          for (int r = 0; r < 16; ++r) acc[a][c][r] = 0.f;
      gemm_accum_wide(acc, A + (size_t)mt * 128 * lda, lda, Wt + (size_t)nt * 256 * lda, lda, nk * 2, sA, sB);
      const int t2 = opaque(threadIdx.x), wm = t2 >> 7, wn = (t2 >> 6) & 1, hq = (t2 >> 5) & 1, lq = t2 & 31;
#pragma unroll
      for (int mi = 0; mi < 2; ++mi)
#pragma unroll
        for (int ni = 0; ni < 4; ++ni) {
          bf16_t* dst = O + (size_t)(mt * 128 + wm * 64 + mi * 32) * D + nt * 256 + wn * 128 + ni * 32 + lq;
#pragma unroll
          for (int r = 0; r < 16; ++r) dst[(size_t)crow(r, hq) * D] = f2bf(acc[mi][ni][r]);
        }
    }
  }
  bf16_t* sA = (bf16_t*)smem; bf16_t* sB = sA + 2 * LTILE;
  const int lane = threadIdx.x & 63, wave = threadIdx.x >> 6, wm = wave >> 1, wn = wave & 1, h = lane >> 5;
  if (l == 0) {
    for (int u = (nb - 1 - bid); u < 128; u += nb) {
      const int c = u & 7, nt64 = u >> 3;
      const int mt = (c >> 1) * 34 + 32 + (c & 1);
      f32x16 acc[2];
#pragma unroll
      for (int a = 0; a < 2; ++a)
#pragma unroll
        for (int r = 0; r < 16; ++r) acc[a][r] = 0.f;
      gemm_accum_n64(acc, A + (size_t)mt * 128 * lda, lda, Wt + (size_t)nt64 * 64 * lda, lda, nk, sA, sB);
      const int hq = opaque(h), lq = opaque(lane & 31);
#pragma unroll
      for (int mi = 0; mi < 2; ++mi) {
        bf16_t* dst = O + (size_t)(mt * 128 + wm * 64 + mi * 32) * D + nt64 * 64 + wn * 32 + lq;
#pragma unroll
        for (int r = 0; r < 16; ++r) dst[(size_t)crow(r, hq) * D] = f2bf(acc[mi][r]);
      }
    }
  }
}

DI void phase_gemm4(const Params& p, int l, int bid, int nb, char* smem) {
  bf16_t* sA = (bf16_t*)smem; bf16_t* sB = sA + 2 * WA_STG;
  const bf16_t* H = ws_b(p, OFF_H);
  bf16_t* ACT = ws_b(p, OFF_X2);
  const bool lat = (l == 1);
  const int nmt = lat ? 128 : 136;
  for (int idx = bid >> 3; idx < (nmt >> 3) * 22; idx += nb >> 3) {
    int mtl, nt; decode_tile(idx, bid & 7, nmt, 22, mtl, nt);
    const int mt = map_mtile(mtl, lat);
    f32x16 acc[2][4];
#pragma unroll
    for (int a = 0; a < 2; ++a)
#pragma unroll
      for (int c = 0; c < 4; ++c)
#pragma unroll
        for (int r = 0; r < 16; ++r) acc[a][c][r] = 0.f;
    gemm_accum_wide(acc, H + (size_t)mt * 128 * D, D, wb(p, W_GU) + (size_t)nt * 256 * 1024, 1024, 32, sA, sB);
    const int t2 = opaque(threadIdx.x), wm = t2 >> 7, wn = (t2 >> 6) & 1, hq = (t2 >> 5) & 1, lq = t2 & 31;
#pragma unroll
    for (int mi = 0; mi < 2; ++mi)
#pragma unroll
      for (int j = 0; j < 2; ++j) {
        bf16_t* dst = ACT + (size_t)(mt * 128 + wm * 64 + mi * 32) * DFF + (nt * 4 + wn * 2 + j) * 32 + lq;
#pragma unroll
        for (int r = 0; r < 16; ++r) {
          const float g = acc[mi][2 * j][r], u = acc[mi][2 * j + 1][r];
          dst[(size_t)crow(r, hq) * DFF] = f2bf(g / (1.f + __expf(-g)) * u);
        }
      }
  }
}

DI void phase_ln(const Params& p, int l, int bid, int nb, const bf16_t* O, int gate_off, const float* lng, const float* lnb, int hl, int hsh_off, int hsc_off, bool src_is_input) {
  const int lane = threadIdx.x & 63, wave = threadIdx.x >> 6;
  bf16_t* H = ws_b(p, OFF_H);
  const float* mod = ws_f(p, OFF_MOD);
  float4 lg[4], lb[4];
#pragma unroll
  for (int i = 0; i < 4; ++i) { const int c = (i * 64 + lane) * 4; lg[i] = *(const float4*)(lng + c); lb[i] = *(const float4*)(lnb + c); }
  const int stride = nb * 4;
  for (int row0 = bid * 4 + wave; row0 < MROWS; row0 += 2 * stride) {
    int rw[2], bb[2], tt[2]; bool ok[2];
#pragma unroll
    for (int k = 0; k < 2; ++k) {
      rw[k] = row0 + k * stride;
      const int rr = min(rw[k], MROWS - 1);
      bb[k] = rr / TT; tt[k] = rr % TT;
      ok[k] = (rw[k] < MROWS) && !(l == 1 && tt[k] >= SEQ);
    }
    float v[2][16];
    float s[2] = {0.f, 0.f};
#pragma unroll
    for (int k = 0; k < 2; ++k) {
      if (!ok[k]) continue;
      const int j = tt[k] < SEQ ? bb[k] : 4;
      const float* src = xsrc_row(p, src_is_input ? 0 : 1, bb[k], tt[k]);
      const float* mg = mod + (size_t)(l * 5 + j) * 6144 + gate_off;
#pragma unroll
      for (int i = 0; i < 4; ++i) {
        const int c = (i * 64 + lane) * 4;
        const float4 x = *(const float4*)(src + c);
        const float4 g = *(const float4*)(mg + c);
        const uint2 ob = *(const uint2*)(O + (size_t)rw[k] * D + c);
        v[k][i * 4 + 0] = ALPHA * x.x + g.x * __uint_as_float(ob.x << 16);
        v[k][i * 4 + 1] = ALPHA * x.y + g.y * __uint_as_float(ob.x & 0xffff0000u);
        v[k][i * 4 + 2] = ALPHA * x.z + g.z * __uint_as_float(ob.y << 16);
        v[k][i * 4 + 3] = ALPHA * x.w + g.w * __uint_as_float(ob.y & 0xffff0000u);
        s[k] += v[k][i * 4] + v[k][i * 4 + 1] + v[k][i * 4 + 2] + v[k][i * 4 + 3];
      }
    }
    float mu[2], rstd[2];
#pragma unroll
    for (int k = 0; k < 2; ++k) mu[k] = wave_sum(s[k]) * (1.f / 1024.f);
    float q[2] = {0.f, 0.f};
#pragma unroll
    for (int k = 0; k < 2; ++k)
#pragma unroll
      for (int i = 0; i < 16; ++i) { v[k][i] -= mu[k]; q[k] += v[k][i] * v[k][i]; }
#pragma unroll
    for (int k = 0; k < 2; ++k) rstd[k] = rsqrtf(wave_sum(q[k]) * (1.f / 1024.f) + EPS);
#pragma unroll
    for (int k = 0; k < 2; ++k) {
      if (!ok[k]) continue;
      const int j = tt[k] < SEQ ? bb[k] : 4;
      float* dst = xdst_row(p, bb[k], tt[k]);
      const float* mh = (hl >= 0) ? mod + (size_t)(hl * 5 + j) * 6144 : mod;
#pragma unroll
      for (int i = 0; i < 4; ++i) {
        const int c = (i * 64 + lane) * 4;
        float4 y;
        y.x = v[k][i * 4 + 0] * rstd[k] * lg[i].x + lb[i].x; y.y = v[k][i * 4 + 1] * rstd[k] * lg[i].y + lb[i].y;
        y.z = v[k][i * 4 + 2] * rstd[k] * lg[i].z + lb[i].z; y.w = v[k][i * 4 + 3] * rstd[k] * lg[i].w + lb[i].w;
        *(float4*)(dst + c) = y;
        if (hl >= 0) {
          const float4 sh = *(const float4*)(mh + hsh_off + c);
          const float4 sc = *(const float4*)(mh + hsc_off + c);
          store_h4(H + (size_t)rw[k] * D + c, y.x * (1.f + sc.x) + sh.x, y.y * (1.f + sc.y) + sh.y, y.z * (1.f + sc.z) + sh.z, y.w * (1.f + sc.w) + sh.w);
        }
      }
    }
  }
}

#define XB_TMO      128
#define XB_XCNT(j)  (256  + 64 * (j))
#define XB_XSUB(j)  (1280 + 64 * (j))
#define XB_XGEN(j)  (2304 + 64 * (j))
#define XB_TOP      3328
#define XB_TOPGEN   3392
#define XCD_BAR_WORDS 3456
#define XB_SPIN_CAP (1u << 18)
#define LAS __attribute__((address_space(3)))
DI unsigned xb_ld(unsigned* p)              { return __hip_atomic_load(p, __ATOMIC_RELAXED, __HIP_MEMORY_SCOPE_AGENT); }
DI unsigned xb_add(unsigned* p, unsigned v) { return __hip_atomic_fetch_add(p, v, __ATOMIC_RELAXED, __HIP_MEMORY_SCOPE_AGENT); }
DI unsigned xb_xcc_id() { return (unsigned)__builtin_amdgcn_s_getreg((3 << 11) | 20) & 0xFu; }
#define XB_SPIN(cond, bar) do { unsigned _sp = 0; while (cond) { __builtin_amdgcn_s_sleep(1); \
    if ((++_sp & 255u) == 0u) { if (xb_ld(&(bar)[XB_TMO])) break; if (_sp > XB_SPIN_CAP) { atomicAdd(&(bar)[XB_TMO], 1u); break; } } } } while (0)
struct XcdBarrier { unsigned* bar; unsigned x; volatile LAS unsigned* st; };
DI XcdBarrier xcd_barrier_post(unsigned* bar, volatile LAS unsigned* st) {
  XcdBarrier b; b.bar = bar; b.x = xb_xcc_id(); b.st = st;
  if (threadIdx.x == 0) (void)xb_add(&bar[XB_XCNT(b.x)], 1u);
  return b;
}
DI void xcd_barrier_complete(unsigned* bar, unsigned x, unsigned& nloc, unsigned& nx) {
  const unsigned G = gridDim.x * gridDim.y * gridDim.z;
  unsigned sum, cnt, mine, sp = 0u;
  for (;;) {
    sum = 0u; cnt = 0u; mine = 0u;
#pragma unroll
    for (unsigned j = 0; j < 16; ++j) { const unsigned c = xb_ld(&bar[XB_XCNT(j)]); sum += c; cnt += (c > 0u) ? 1u : 0u; mine = (j == x) ? c : mine; }
    if (sum == G) break;
    __builtin_amdgcn_s_sleep(1);
    if ((++sp & 255u) == 0u) { if (xb_ld(&bar[XB_TMO])) break; if (sp > XB_SPIN_CAP) { atomicAdd(&bar[XB_TMO], 1u); break; } }
  }
  nloc = mine > 0u ? mine : 1u; nx = cnt > 0u ? cnt : 1u;
}
DI void xcd_barrier(const XcdBarrier& b) {
  asm volatile("s_waitcnt vmcnt(0)" ::: "memory");
  __syncthreads();
  if (threadIdx.x == 0) {
    unsigned* bar = b.bar;
    __builtin_amdgcn_s_waitcnt(0);
    unsigned nloc = b.st[0], nx = b.st[1];
    if (nloc == 0u) { xcd_barrier_complete(bar, b.x, nloc, nx); b.st[0] = nloc; b.st[1] = nx; }
    const unsigned old = xb_add(&bar[XB_XSUB(b.x)], 1u);
    const unsigned gen = old / nloc;
    if (old + 1u == (gen + 1u) * nloc) {
      __builtin_amdgcn_fence(__ATOMIC_RELEASE, "agent");
      asm volatile("s_waitcnt vmcnt(0)" ::: "memory");
      const unsigned og = xb_add(&bar[XB_TOP], 1u);
      const unsigned tg = og / nx;
      if (og + 1u == (tg + 1u) * nx) xb_add(&bar[XB_TOPGEN], 1u);
      else XB_SPIN(xb_ld(&bar[XB_TOPGEN]) == tg, bar);
      __builtin_amdgcn_fence(__ATOMIC_ACQUIRE, "agent");
      xb_add(&bar[XB_XGEN(b.x)], 1u);
      asm volatile("s_waitcnt vmcnt(0)" ::: "memory");
    } else {
      XB_SPIN(xb_ld(&bar[XB_XGEN(b.x)]) == gen, bar);
      __builtin_amdgcn_fence(__ATOMIC_ACQUIRE, "agent");
      asm volatile("s_waitcnt vmcnt(0)" ::: "memory");
    }
  }
  __syncthreads();
}

constexpr int NPHASES = 22;
#define PHASE(idx, body) if (ph_begin <= (idx) && (idx) < ph_end) { body; if ((idx) + 1 < ph_end) { if (ph_end > NPHASES) grid.sync(); else xcd_barrier(xb); } }
template <int L>
DI void run_layer(const Params& p, int ph_begin, int ph_end, int bid, int nb, char* smem, cg::grid_group& grid, const XcdBarrier& xb) {
  constexpr int base = 2 + 10 * L;
  PHASE(base + 0, phase_gemm1(p, bid, nb, smem))
  PHASE(base + 1, phase_rowwise(p, L, bid, nb))
  PHASE(base + 2, { phase_gemm2(p, bid, nb, smem); phase_rowwise_b(p, L, bid, nb); })
  #if NAIVE_ATTN
  PHASE(base + 3, phase_attn_naive(p, L, bid, nb))
#else
  PHASE(base + 3, phase_attn(p, L, bid, nb, smem))
#endif
  PHASE(base + 4, phase_merge(p, L, bid, nb, smem))
  PHASE(base + 5, phase_gemm_plain(p, L, bid, nb, smem, ws_b(p, OFF_S1), 1024, 16, wb(p, W_OUT), ws_b(p, OFF_S0)))
  PHASE(base + 6, phase_ln(p, L, bid, nb, ws_b(p, OFF_S0), 2048, p.ln1_g + L * D, p.ln1_b + L * D, L, 3072, 4096, L == 0))
  PHASE(base + 7, phase_gemm4(p, L, bid, nb, smem))
  PHASE(base + 8, phase_gemm_plain(p, L, bid, nb, smem, ws_b(p, OFF_X2), DFF, 44, wb(p, W_DN), ws_b(p, OFF_S1)))
  PHASE(base + 9, { phase_ln(p, L, bid, nb, ws_b(p, OFF_S1), 5120, p.ln2_g + L * D, p.ln2_b + L * D, (L == 0) ? 1 : -1, 0, 1024, false);
                    if (L == 0) convert_weights(p, 1, bid, nb, smem); })
}
__global__ void __launch_bounds__(NTHREADS, 2) mega(Params p, int ph_begin, int ph_end) {
  __shared__ __attribute__((aligned(1024))) char smem[73728];
  cg::grid_group grid = cg::this_grid();
  const int bid = blockIdx.x, nb = gridDim.x;
  __shared__ uint4 xb_words;
  if (threadIdx.x == 0) xb_words = make_uint4(0u, 0u, 0u, 0u);
  __syncthreads();
  const XcdBarrier xb = xcd_barrier_post((unsigned*)(p.ws + OFF_BAR), (volatile LAS unsigned*)&xb_words);
  PHASE(0, phase_prologue(p, bid, nb, smem))
  PHASE(1, phase_modulate0(p, bid, nb))
  run_layer<0>(p, ph_begin, ph_end, bid, nb, smem, grid, xb);
  run_layer<1>(p, ph_begin, ph_end, bid, nb, smem, grid, xb);
}

extern "C" void kernel_launch(void* const* d_in, const int* in_sizes, int n_in, void* d_out, int out_size, void* d_ws, size_t ws_size, hipStream_t stream) {
  Params p{};
  const float** pp = (const float**)&p;
  for (int i = 0; i < 27; ++i) pp[i] = (const float*)d_in[i];
  p.out = (float*)d_out;
  p.ws = (char*)d_ws;
  static int grid_blocks = 0;
  if (!grid_blocks) {
    int dev = 0, cus = 0, per_cu = 0;
    hipGetDevice(&dev);
    hipDeviceGetAttribute(&cus, hipDeviceAttributeMultiprocessorCount, dev);
    hipOccupancyMaxActiveBlocksPerMultiprocessor(&per_cu, mega, NTHREADS, 0);
    if (per_cu < 1) per_cu = 1;
    grid_blocks = cus * per_cu;
  }
  hipMemsetAsync((char*)d_ws + OFF_BAR, 0, (XCD_BAR_WORDS + 128) * 4, stream);
#if COOP
  int b = 0, e = NPHASES;
  void* args[] = {&p, &b, &e};
  hipError_t err = hipLaunchCooperativeKernel((void*)mega, dim3(grid_blocks), dim3(NTHREADS), args, 0, stream);
  if (err != hipSuccess) fprintf(stderr, "cooperative launch failed: %s (grid %d)\n", hipGetErrorString(err), grid_blocks);
#else
  for (int ph = 0; ph < NPHASES; ++ph) mega<<<grid_blocks, NTHREADS, 0, stream>>>(p, ph, ph + 1);
#endif
}
```

```cpp
#include <hip/hip_runtime.h>
#include <hip/hip_cooperative_groups.h>
#include <cstdio>
namespace cg = cooperative_groups;

#ifndef COOP
#define COOP 1
#endif
#ifndef NAIVE_ATTN
#define NAIVE_ATTN 0
#endif

#define DI __device__ __forceinline__
typedef unsigned short bf16_t;
using bf16x8 = __attribute__((ext_vector_type(8))) short;
using f32x16 = __attribute__((ext_vector_type(16))) float;
#define MFMA32(a, b, c) __builtin_amdgcn_mfma_f32_32x32x16_bf16((a), (b), (c), 0, 0, 0)

constexpr int D = 1024, NB = 4, SEQ = 4096, CTX = 256, TT = 4352, MROWS = 17408;
constexpr int DIN = 6816, NPROJ = 2720, DFF = 2816, RW = 672;
constexpr float EPS = 1e-6f;
constexpr float ALPHA = 1.4142135623730951f;
constexpr int NTHREADS = 256;

constexpr size_t OFF_MOD = 0;
constexpr size_t OFF_T32 = OFF_MOD + 245760;
constexpr size_t OFF_T64 = OFF_T32 + 4096;
constexpr size_t OFF_LAM = OFF_T64 + 8192;
constexpr size_t OFF_XC  = OFF_LAM + 256;
constexpr size_t OFF_WB  = OFF_XC + 4194304;
constexpr size_t W_IN = 0, W_QUP = 6979584, W_KVUP = 7127040, W_BR = 7258112, W_OUT = 8306688, W_GU = 9355264, W_DN = 15122432, W_END = 18006016;
constexpr size_t OFF_H   = OFF_WB + W_END * 2;
constexpr size_t OFF_S0  = OFF_H + 35651584;
constexpr size_t OFF_S1  = OFF_S0 + 35651584;
constexpr size_t OFF_X2  = OFF_S1 + 35651584;
constexpr size_t OFF_BAR = OFF_X2 + 106954752;
constexpr int XCD_BAR_WORDS_C = 3456;
constexpr size_t E64 = 4456448, E96 = 6684672, E2H = 2228224;
constexpr size_t Q_A = 0, K_A = E96, V_A = 2 * E96, Q_B = V_A + E64, K_B = Q_B + E64, V_B = K_B + E64,
                 Q_C = V_B + E64, K_C = Q_C + E64, V_C = K_C + E64, Q_D = V_C + E64, K_D = Q_D + E64, V_D = K_D + E2H;

struct Params {
  const float *x, *c, *ctx, *c_ctx, *w_ada, *b_ada, *w_in, *g_q_a, *w_q_up, *g_kv_a, *w_kv_up, *rpb,
      *lam_q1, *lam_k1, *lam_q2, *lam_k2, *g_sub, *g_qn, *g_kn, *w_branch, *w_out, *ln1_g, *ln1_b,
      *w_gate_up, *w_down, *ln2_g, *ln2_b;
  float* out;
  char* ws;
};

DI float fast_sigmoid(float x) { return __builtin_amdgcn_rcpf(1.f + __expf(-x)); }
DI float bf2f(bf16_t b) { return __uint_as_float(((unsigned)b) << 16); }
DI bf16_t f2bf(float x) { return __builtin_bit_cast(unsigned short, (__bf16)x); }
typedef __bf16 bf16x2_t __attribute__((ext_vector_type(2)));
typedef float f32x2_t __attribute__((ext_vector_type(2)));
DI unsigned pack2(float a, float b) { f32x2_t v = {a, b}; return __builtin_bit_cast(unsigned, __builtin_convertvector(v, bf16x2_t)); }
DI float xhalf_max(float x) { auto r = __builtin_amdgcn_permlane32_swap(__float_as_uint(x), __float_as_uint(x), false, false); return fmaxf(__uint_as_float(r[0]), __uint_as_float(r[1])); }
DI float xhalf_sum(float x) { auto r = __builtin_amdgcn_permlane32_swap(__float_as_uint(x), __float_as_uint(x), false, false); return __uint_as_float(r[0]) + __uint_as_float(r[1]); }
template <int CTRL> DI float dpp_mov(float x) { return __int_as_float(__builtin_amdgcn_update_dpp(0, __float_as_int(x), CTRL, 0xF, 0xF, true)); }
DI float xhalf_sum(float x);
DI float wave_sum(float v) {
  v += dpp_mov<0xB1>(v);
  v += dpp_mov<0x4E>(v);
  v += dpp_mov<0x141>(v);
  v += dpp_mov<0x140>(v);
  v += __shfl_xor(v, 16);
  return xhalf_sum(v);
}
DI int opaque(int x) { asm volatile("" : "+v"(x)); return x; }
DI int crow(int reg, int h) { return (reg & 3) + 8 * (reg >> 2) + 4 * h; }
DI float lam_init_of(int l) { return l == 0 ? 0.2f : 0.35550907f; }

DI float* ws_f(const Params& p, size_t off) { return (float*)(p.ws + off); }
DI bf16_t* ws_b(const Params& p, size_t off) { return (bf16_t*)(p.ws + off); }
DI bf16_t* qkv(const Params& p, size_t eoff) { return (bf16_t*)(p.ws + OFF_X2) + eoff; }
DI bf16_t* wb(const Params& p, size_t eoff) { return (bf16_t*)(p.ws + OFF_WB) + eoff; }

DI const float* xsrc_row(const Params& p, int l, int b, int t) {
  if (l == 0) return t < SEQ ? p.x + ((size_t)b * SEQ + t) * D : p.ctx + ((size_t)b * CTX + (t - SEQ)) * D;
  return t < SEQ ? p.out + ((size_t)b * SEQ + t) * D : ws_f(p, OFF_XC) + ((size_t)b * CTX + (t - SEQ)) * D;
}
DI float* xdst_row(const Params& p, int b, int t) {
  return t < SEQ ? p.out + ((size_t)b * SEQ + t) * D : ws_f(p, OFF_XC) + ((size_t)b * CTX + (t - SEQ)) * D;
}

DI void conv_unit(const float* __restrict__ src, int ld_src, int k0, int n0, bf16_t* __restrict__ dst, int ld_dst, int ndst0, float* tile) {
  const int tid = threadIdx.x;
  {
    const int n = tid & 31, kb = tid >> 5;
    float v[16];
#pragma unroll
    for (int i = 0; i < 16; ++i) v[i] = src[(size_t)(k0 + kb + 8 * i) * ld_src + n0 + n];
#pragma unroll
    for (int i = 0; i < 16; ++i) tile[(kb + 8 * i) * 33 + n] = v[i];
  }
  __syncthreads();
  {
    const int nn = tid >> 3, kc = tid & 7;
    float v[16];
#pragma unroll
    for (int j = 0; j < 16; ++j) v[j] = tile[(kc * 16 + j) * 33 + nn];
    uint4 o0, o1;
    o0.x = pack2(v[0], v[1]); o0.y = pack2(v[2], v[3]); o0.z = pack2(v[4], v[5]); o0.w = pack2(v[6], v[7]);
    o1.x = pack2(v[8], v[9]); o1.y = pack2(v[10], v[11]); o1.z = pack2(v[12], v[13]); o1.w = pack2(v[14], v[15]);
    bf16_t* d = dst + (size_t)(ndst0 + nn) * ld_dst + k0 + kc * 16;
    *(uint4*)d = o0; *(uint4*)(d + 8) = o1;
  }
  __syncthreads();
}

DI void convert_weights(const Params& p, int l, int bid, int nb, char* smem) {
  float* tile = (float*)smem;
  int* s_u = (int*)(smem + 128 * 33 * 4);
  unsigned* ctr = (unsigned*)(p.ws + OFF_BAR) + XCD_BAR_WORDS_C + 64 * l;
  for (;;) {
    if (threadIdx.x == 0) *s_u = (int)__hip_atomic_fetch_add(ctr, 1u, __ATOMIC_RELAXED, __HIP_MEMORY_SCOPE_AGENT);
    __syncthreads();
    const int u = *s_u;
    __syncthreads();
    if (u >= 4396) break;
    int v = u;
    if (v < 1704) { int kt = v / 213, nt = v % 213; conv_unit(p.w_in + (size_t)l * 1024 * DIN, DIN, kt * 128, nt * 32, wb(p, W_IN), 1024, nt * 32, tile); continue; }
    v -= 1704;
    if (v < 36) { int kt = v / 12, nt = v % 12; conv_unit(p.w_q_up + (size_t)l * 384 * 384, 384, kt * 128, nt * 32, wb(p, W_QUP), 384, nt * 32, tile); continue; }
    v -= 36;
    if (v < 32) { int kt = v / 16, nt = v % 16; conv_unit(p.w_kv_up + (size_t)l * 256 * 512, 512, kt * 128, nt * 32, wb(p, W_KVUP), 256, nt * 32, tile); continue; }
    v -= 32;
    if (v < 256) { int i = v / 64, r = v % 64, kt = r / 32, nt = r % 32;
      conv_unit(p.w_branch + (size_t)(l * 4 + i) * 256 * 1024, 1024, kt * 128, nt * 32, wb(p, W_BR) + (size_t)i * 1024 * 256, 256, nt * 32, tile); continue; }
    v -= 256;
    if (v < 256) { int kt = v / 32, nt = v % 32; conv_unit(p.w_out + (size_t)l * 1024 * 1024, 1024, kt * 128, nt * 32, wb(p, W_OUT), 1024, nt * 32, tile); continue; }
    v -= 256;
    if (v < 1408) { int kt = v / 176, nt = v % 176; int nd = (nt < 88) ? nt * 64 : (nt - 88) * 64 + 32;
      conv_unit(p.w_gate_up + (size_t)l * 1024 * 5632, 5632, kt * 128, nt * 32, wb(p, W_GU), 1024, nd, tile); continue; }
    v -= 1408;
    { int kt = v / 32, nt = v % 32; conv_unit(p.w_down + (size_t)l * DFF * 1024, 1024, kt * 128, nt * 32, wb(p, W_DN), DFF, nt * 32, tile); }
  }
}

DI void phase_prologue(const Params& p, int bid, int nb, char* smem) {
  const int tid = threadIdx.x;
  float* sc = (float*)smem;
  float* red = sc + 5120;
  if (bid < 384) {
    for (int i = tid; i < 5120; i += NTHREADS) {
      const int j = i >> 10, k = i & 1023;
      const float v = (j < 4) ? p.c[j * 1024 + k] : p.c_ctx[k];
      sc[i] = v / (1.f + expf(-v));
    }
    __syncthreads();
    float* mod = ws_f(p, OFF_MOD);
    for (int u = bid; u < 384; u += nb) {
      const int l = u / 192, grp = u % 192, nn = tid & 31, kq = tid >> 5, n = grp * 32 + nn;
      const float* w = p.w_ada + ((size_t)l * 1024 + kq * 128) * 6144 + n;
      float s0 = 0, s1 = 0, s2 = 0, s3 = 0, s4 = 0;
#pragma unroll 16
      for (int k = 0; k < 128; ++k) {
        const float wv = w[(size_t)k * 6144];
        const int kk = kq * 128 + k;
        s0 += sc[kk] * wv; s1 += sc[1024 + kk] * wv; s2 += sc[2048 + kk] * wv; s3 += sc[3072 + kk] * wv; s4 += sc[4096 + kk] * wv;
      }
      red[(kq * 5 + 0) * 32 + nn] = s0; red[(kq * 5 + 1) * 32 + nn] = s1; red[(kq * 5 + 2) * 32 + nn] = s2;
      red[(kq * 5 + 3) * 32 + nn] = s3; red[(kq * 5 + 4) * 32 + nn] = s4;
      __syncthreads();
      if (tid < 160) {
        const int j = tid >> 5, c = tid & 31;
        float acc = p.b_ada[l * 6144 + grp * 32 + c];
#pragma unroll
        for (int q = 0; q < 8; ++q) acc += red[(q * 5 + j) * 32 + c];
        mod[(size_t)(l * 5 + j) * 6144 + grp * 32 + c] = acc;
      }
      __syncthreads();
    }
  }
  if (bid == nb - 1) {
    float2* t32 = (float2*)(p.ws + OFF_T32);
    float2* t64 = (float2*)(p.ws + OFF_T64);
    for (int i = tid; i < 512; i += NTHREADS) { const int pos = i >> 3, f = i & 7; const float inv = powf(10000.f, -(float)f / 8.f); const float a = (float)pos * inv; t32[i] = make_float2(cosf(a), sinf(a)); }
    for (int i = tid; i < 1024; i += NTHREADS) { const int pos = i >> 4, f = i & 15; const float inv = powf(10000.f, -(float)f / 16.f); const float a = (float)pos * inv; t64[i] = make_float2(cosf(a), sinf(a)); }
    if (tid < 8) {
      const int l = tid >> 2, h = tid & 3;
      float a = 0, b2 = 0;
      for (int e = 0; e < 32; ++e) { a += p.lam_q1[(l * 4 + h) * 32 + e] * p.lam_k1[(l * 4 + h) * 32 + e]; b2 += p.lam_q2[(l * 4 + h) * 32 + e] * p.lam_k2[(l * 4 + h) * 32 + e]; }
      ws_f(p, OFF_LAM)[tid] = expf(a) - expf(b2) + lam_init_of(l);
    }
  }
  __syncthreads();
  convert_weights(p, 0, bid, nb, smem);
}

DI void store_h4(bf16_t* dst, float a, float b, float c, float d) { uint2 o; o.x = pack2(a, b); o.y = pack2(c, d); *(uint2*)dst = o; }

DI void phase_modulate0(const Params& p, int bid, int nb) {
  const int lane = threadIdx.x & 63, wave = threadIdx.x >> 6;
  bf16_t* H = ws_b(p, OFF_H);
  const float* mod = ws_f(p, OFF_MOD);
  for (int row = bid * 4 + wave; row < MROWS; row += nb * 4) {
    const int b = row / TT, t = row % TT;
    const float* src = xsrc_row(p, 0, b, t);
    const float* m = mod + (size_t)(0 * 5 + (t < SEQ ? b : 4)) * 6144;
#pragma unroll
    for (int i = 0; i < 4; ++i) {
      const int c = (i * 64 + lane) * 4;
      const float4 x = *(const float4*)(src + c);
      const float4 sh = *(const float4*)(m + c);
      const float4 s = *(const float4*)(m + 1024 + c);
      store_h4(H + (size_t)row * D + c, x.x * (1.f + s.x) + sh.x, x.y * (1.f + s.y) + sh.y, x.z * (1.f + s.z) + sh.z, x.w * (1.f + s.w) + sh.w);
    }
  }
}

constexpr int LROW = 64;
constexpr int LTILE = 128 * LROW;
#define WAIT_V0() asm volatile("s_waitcnt vmcnt(0)" ::: "memory")
#define GLDS16(gp, lp) __builtin_amdgcn_global_load_lds((const unsigned*)(gp), (unsigned*)(lp), 16, 0, 0)
#define STAGE_A(buf, kt) { _Pragma("unroll") for (int i = 0; i < 4; ++i) GLDS16(ga + (size_t)(32 * i) * lda + (kt) * 64, sA + (buf) * LTILE + (i * 32 + wave * 8) * LROW); }
#define STAGE_B(buf, kt, NI) { _Pragma("unroll") for (int i = 0; i < (NI); ++i) GLDS16(gb + (size_t)(32 * i) * ldb + (kt) * 64, sB + (buf) * LTILE + (i * 32 + wave * 8) * LROW); }
#define CORE_SETUP() \
  const int tid = opaque(threadIdx.x), lane = tid & 63, wave = tid >> 6; \
  const int wm = wave >> 1, wn = wave & 1; \
  const int srow = tid >> 3, skc = (tid & 7) ^ ((srow >> 1) & 7); \
  const bf16_t* ga = A + (size_t)srow * lda + skc * 8; \
  const bf16_t* gb = B + (size_t)srow * ldb + skc * 8; \
  const int l31 = lane & 31, fh = lane >> 5, fsw = (lane >> 1) & 7; \
  const int c0 = ((0 + fh) ^ fsw) * 8, c1 = ((2 + fh) ^ fsw) * 8, c2 = ((4 + fh) ^ fsw) * 8, c3 = ((6 + fh) ^ fsw) * 8;

#define LDSA(p) ((unsigned)(size_t)(p))
DI void lds_read16(bf16x8& a00, bf16x8& a01, bf16x8& b00, bf16x8& b01, bf16x8& a10, bf16x8& a11, bf16x8& b10, bf16x8& b11,
                   bf16x8& a20, bf16x8& a21, bf16x8& b20, bf16x8& b21, bf16x8& a30, bf16x8& a31, bf16x8& b30, bf16x8& b31,
                   unsigned pa0, unsigned pa1, unsigned pa2, unsigned pa3, unsigned pb0, unsigned pb1, unsigned pb2, unsigned pb3) {
  asm volatile(
      "ds_read_b128 %0, %16\n\tds_read_b128 %1, %16 offset:4096\n\tds_read_b128 %2, %20\n\tds_read_b128 %3, %20 offset:4096\n\t"
      "ds_read_b128 %4, %17\n\tds_read_b128 %5, %17 offset:4096\n\tds_read_b128 %6, %21\n\tds_read_b128 %7, %21 offset:4096\n\t"
      "ds_read_b128 %8, %18\n\tds_read_b128 %9, %18 offset:4096\n\tds_read_b128 %10, %22\n\tds_read_b128 %11, %22 offset:4096\n\t"
      "ds_read_b128 %12, %19\n\tds_read_b128 %13, %19 offset:4096\n\tds_read_b128 %14, %23\n\tds_read_b128 %15, %23 offset:4096"
      : "=&v"(a00), "=&v"(a01), "=&v"(b00), "=&v"(b01), "=&v"(a10), "=&v"(a11), "=&v"(b10), "=&v"(b11),
        "=&v"(a20), "=&v"(a21), "=&v"(b20), "=&v"(b21), "=&v"(a30), "=&v"(a31), "=&v"(b30), "=&v"(b31)
      : "v"(pa0), "v"(pa1), "v"(pa2), "v"(pa3), "v"(pb0), "v"(pb1), "v"(pb2), "v"(pb3)
      : "memory");
}
#define LGKM_WAIT4(n, x0, x1, x2, x3) asm volatile("s_waitcnt lgkmcnt(" #n ")" : "+v"(x0), "+v"(x1), "+v"(x2), "+v"(x3))
DI void lds_read4(bf16x8& a0, bf16x8& a1, bf16x8& b0, bf16x8& b1, unsigned pa, unsigned pb) {
  asm volatile("ds_read_b128 %0, %4\n\tds_read_b128 %1, %4 offset:4096\n\tds_read_b128 %2, %5\n\tds_read_b128 %3, %5 offset:4096\n\ts_waitcnt lgkmcnt(0)"
               : "=&v"(a0), "=&v"(a1), "=&v"(b0), "=&v"(b1) : "v"(pa), "v"(pb) : "memory");
}
DI void lds_read3(bf16x8& a0, bf16x8& a1, bf16x8& b0, unsigned pa, unsigned pb) {
  asm volatile("ds_read_b128 %0, %3\n\tds_read_b128 %1, %3 offset:4096\n\tds_read_b128 %2, %4\n\ts_waitcnt lgkmcnt(0)"
               : "=&v"(a0), "=&v"(a1), "=&v"(b0) : "v"(pa), "v"(pb) : "memory");
}

DI void gemm_accum(f32x16 (&acc)[2][2], const bf16_t* __restrict__ A, int lda, const bf16_t* __restrict__ B, int ldb, int nk, bf16_t* sA, bf16_t* sB) {
  CORE_SETUP()
  STAGE_A(0, 0) STAGE_B(0, 0, 4)
  WAIT_V0(); __syncthreads();
  const unsigned la = LDSA(sA) + (wm * 64 + l31) * (LROW * 2), lb = LDSA(sB) + (wn * 64 + l31) * (LROW * 2);
#pragma unroll 1
  for (int kt = 0; kt < nk; ++kt) {
    const int cur = kt & 1;
    if (kt + 1 < nk) { STAGE_A(cur ^ 1, kt + 1) STAGE_B(cur ^ 1, kt + 1, 4) }
    const unsigned pa = la + cur * (LTILE * 2), pb = lb + cur * (LTILE * 2);
    bf16x8 a00, a01, b00, b01, a10, a11, b10, b11, a20, a21, b20, b21, a30, a31, b30, b31;
    lds_read16(a00, a01, b00, b01, a10, a11, b10, b11, a20, a21, b20, b21, a30, a31, b30, b31,
               pa + c0 * 2, pa + c1 * 2, pa + c2 * 2, pa + c3 * 2, pb + c0 * 2, pb + c1 * 2, pb + c2 * 2, pb + c3 * 2);
    LGKM_WAIT4(12, a00, a01, b00, b01);
    __builtin_amdgcn_s_setprio(1);
    acc[0][0] = MFMA32(a00, b00, acc[0][0]); acc[0][1] = MFMA32(a00, b01, acc[0][1]); acc[1][0] = MFMA32(a01, b00, acc[1][0]); acc[1][1] = MFMA32(a01, b01, acc[1][1]);
    __builtin_amdgcn_sched_barrier(0);
    LGKM_WAIT4(8, a10, a11, b10, b11);
    acc[0][0] = MFMA32(a10, b10, acc[0][0]); acc[0][1] = MFMA32(a10, b11, acc[0][1]); acc[1][0] = MFMA32(a11, b10, acc[1][0]); acc[1][1] = MFMA32(a11, b11, acc[1][1]);
    __builtin_amdgcn_sched_barrier(0);
    LGKM_WAIT4(4, a20, a21, b20, b21);
    acc[0][0] = MFMA32(a20, b20, acc[0][0]); acc[0][1] = MFMA32(a20, b21, acc[0][1]); acc[1][0] = MFMA32(a21, b20, acc[1][0]); acc[1][1] = MFMA32(a21, b21, acc[1][1]);
    __builtin_amdgcn_sched_barrier(0);
    LGKM_WAIT4(0, a30, a31, b30, b31);
    acc[0][0] = MFMA32(a30, b30, acc[0][0]); acc[0][1] = MFMA32(a30, b31, acc[0][1]); acc[1][0] = MFMA32(a31, b30, acc[1][0]); acc[1][1] = MFMA32(a31, b31, acc[1][1]);
    __builtin_amdgcn_s_setprio(0);
    __builtin_amdgcn_sched_barrier(0);
    WAIT_V0(); __syncthreads();
  }
}
DI void lds_read8(bf16x8& a00, bf16x8& a01, bf16x8& b00, bf16x8& b01, bf16x8& a10, bf16x8& a11, bf16x8& b10, bf16x8& b11,
                  unsigned pa0, unsigned pa1, unsigned pb0, unsigned pb1) {
  asm volatile(
      "ds_read_b128 %0, %8\n\tds_read_b128 %1, %8 offset:4096\n\tds_read_b128 %2, %10\n\tds_read_b128 %3, %10 offset:4096\n\t"
      "ds_read_b128 %4, %9\n\tds_read_b128 %5, %9 offset:4096\n\tds_read_b128 %6, %11\n\tds_read_b128 %7, %11 offset:4096"
      : "=&v"(a00), "=&v"(a01), "=&v"(b00), "=&v"(b01), "=&v"(a10), "=&v"(a11), "=&v"(b10), "=&v"(b11)
      : "v"(pa0), "v"(pa1), "v"(pb0), "v"(pb1) : "memory");
}
DI void gemm_accum_lite(f32x16 (&acc)[2][2], const bf16_t* __restrict__ A, int lda, const bf16_t* __restrict__ B, int ldb, int nk, bf16_t* sA, bf16_t* sB) {
  CORE_SETUP()
  STAGE_A(0, 0) STAGE_B(0, 0, 4)
  WAIT_V0(); __syncthreads();
  const unsigned la = LDSA(sA) + (wm * 64 + l31) * (LROW * 2), lb = LDSA(sB) + (wn * 64 + l31) * (LROW * 2);
#pragma unroll 1
  for (int kt = 0; kt < nk; ++kt) {
    const int cur = kt & 1;
    if (kt + 1 < nk) { STAGE_A(cur ^ 1, kt + 1) STAGE_B(cur ^ 1, kt + 1, 4) }
    const unsigned pa = la + cur * (LTILE * 2), pb = lb + cur * (LTILE * 2);
#pragma unroll
    for (int g = 0; g < 2; ++g) {
      const int ca = g ? c2 : c0, cb = g ? c3 : c1;
      bf16x8 a00, a01, b00, b01, a10, a11, b10, b11;
      lds_read8(a00, a01, b00, b01, a10, a11, b10, b11, pa + ca * 2, pa + cb * 2, pb + ca * 2, pb + cb * 2);
      LGKM_WAIT4(4, a00, a01, b00, b01);
      __builtin_amdgcn_s_setprio(1);
      acc[0][0] = MFMA32(a00, b00, acc[0][0]); acc[0][1] = MFMA32(a00, b01, acc[0][1]); acc[1][0] = MFMA32(a01, b00, acc[1][0]); acc[1][1] = MFMA32(a01, b01, acc[1][1]);
      __builtin_amdgcn_sched_barrier(0);
      LGKM_WAIT4(0, a10, a11, b10, b11);
      acc[0][0] = MFMA32(a10, b10, acc[0][0]); acc[0][1] = MFMA32(a10, b11, acc[0][1]); acc[1][0] = MFMA32(a11, b10, acc[1][0]); acc[1][1] = MFMA32(a11, b11, acc[1][1]);
      __builtin_amdgcn_s_setprio(0);
      __builtin_amdgcn_sched_barrier(0);
    }
    WAIT_V0(); __syncthreads();
  }
}
DI void zero_acc(f32x16 (&acc)[2][2]) {
#pragma unroll
  for (int a = 0; a < 2; ++a)
#pragma unroll
    for (int b = 0; b < 2; ++b)
#pragma unroll
      for (int i = 0; i < 16; ++i) acc[a][b][i] = 0.f;
}

DI void gemm_accum_n64(f32x16 (&acc)[2], const bf16_t* __restrict__ A, int lda, const bf16_t* __restrict__ B, int ldb, int nk, bf16_t* sA, bf16_t* sB) {
  CORE_SETUP()
  STAGE_A(0, 0) STAGE_B(0, 0, 2)
  WAIT_V0(); __syncthreads();
  const unsigned la = LDSA(sA) + (wm * 64 + l31) * (LROW * 2), lb = LDSA(sB) + (wn * 32 + l31) * (LROW * 2);
#pragma unroll 1
  for (int kt = 0; kt < nk; ++kt) {
    const int cur = kt & 1;
    if (kt + 1 < nk) { STAGE_A(cur ^ 1, kt + 1) STAGE_B(cur ^ 1, kt + 1, 2) }
    const unsigned pa = la + cur * (LTILE * 2), pb = lb + cur * (LTILE * 2);
#pragma unroll
    for (int kk = 0; kk < 4; ++kk) {
      const int ck = (kk == 0) ? c0 : (kk == 1) ? c1 : (kk == 2) ? c2 : c3;
      bf16x8 a0, a1, b0;
      lds_read3(a0, a1, b0, pa + ck * 2, pb + ck * 2);
      acc[0] = MFMA32(a0, b0, acc[0]); acc[1] = MFMA32(a1, b0, acc[1]);
      __builtin_amdgcn_sched_barrier(0);
    }
    WAIT_V0(); __syncthreads();
  }
}

constexpr int WA_STG = 128 * 32, WB_STG = 256 * 32;
#define WSTAGE_A(s, kt) { _Pragma("unroll") for (int i = 0; i < 2; ++i) GLDS16(ga + (size_t)(64 * i) * lda + (kt) * 32, sA + (s) * WA_STG + (i * 64 + wave * 16) * 32); }
#define WSTAGE_B(s, kt) { _Pragma("unroll") for (int i = 0; i < 4; ++i) GLDS16(gb + (size_t)(64 * i) * ldb + (kt) * 32, sB + (s) * WB_STG + (i * 64 + wave * 16) * 32); }
#define LGKM_WAIT6(n, x0, x1, x2, x3, x4, x5) asm volatile("s_waitcnt lgkmcnt(" #n ")" : "+v"(x0), "+v"(x1), "+v"(x2), "+v"(x3), "+v"(x4), "+v"(x5))
DI void lds_read12(bf16x8& a00, bf16x8& a01, bf16x8& b00, bf16x8& b01, bf16x8& b02, bf16x8& b03,
                   bf16x8& a10, bf16x8& a11, bf16x8& b10, bf16x8& b11, bf16x8& b12, bf16x8& b13,
                   unsigned pa0, unsigned pa1, unsigned pb0, unsigned pb1) {
  asm volatile(
      "ds_read_b128 %0, %12\n\tds_read_b128 %1, %12 offset:2048\n\t"
      "ds_read_b128 %2, %14\n\tds_read_b128 %3, %14 offset:2048\n\tds_read_b128 %4, %14 offset:4096\n\tds_read_b128 %5, %14 offset:6144\n\t"
      "ds_read_b128 %6, %13\n\tds_read_b128 %7, %13 offset:2048\n\t"
      "ds_read_b128 %8, %15\n\tds_read_b128 %9, %15 offset:2048\n\tds_read_b128 %10, %15 offset:4096\n\tds_read_b128 %11, %15 offset:6144"
      : "=&v"(a00), "=&v"(a01), "=&v"(b00), "=&v"(b01), "=&v"(b02), "=&v"(b03),
        "=&v"(a10), "=&v"(a11), "=&v"(b10), "=&v"(b11), "=&v"(b12), "=&v"(b13)
      : "v"(pa0), "v"(pa1), "v"(pb0), "v"(pb1) : "memory");
}
DI void gemm_accum_wide(f32x16 (&acc)[2][4], const bf16_t* __restrict__ A, int lda, const bf16_t* __restrict__ B, int ldb, int nk32, bf16_t* sA, bf16_t* sB) {
  const int tid = opaque(threadIdx.x), lane = tid & 63, wave = tid >> 6;
  const int wm = wave >> 1, wn = wave & 1;
  const int srow = tid >> 2, skc = (tid & 3) ^ ((srow >> 2) & 3);
  const bf16_t* ga = A + (size_t)srow * lda + skc * 8;
  const bf16_t* gb = B + (size_t)srow * ldb + skc * 8;
  const int l31 = lane & 31, fh = lane >> 5, fsw = (lane >> 2) & 3;
  const unsigned c0 = (unsigned)((fh ^ fsw) * 16), c1 = (unsigned)(((2 + fh) ^ fsw) * 16);
  const unsigned la = LDSA(sA) + (wm * 64 + l31) * 64, lb = LDSA(sB) + (wn * 128 + l31) * 64;
  WSTAGE_A(0, 0) WSTAGE_B(0, 0)
  WAIT_V0(); __syncthreads();
#pragma unroll 1
  for (int kt = 0; kt < nk32; ++kt) {
    const int cur = kt & 1;
    if (kt + 1 < nk32) { WSTAGE_A(cur ^ 1, kt + 1) WSTAGE_B(cur ^ 1, kt + 1) }
    const unsigned pa = la + cur * (WA_STG * 2), pb = lb + cur * (WB_STG * 2);
    bf16x8 a00, a01, b00, b01, b02, b03, a10, a11, b10, b11, b12, b13;
    lds_read12(a00, a01, b00, b01, b02, b03, a10, a11, b10, b11, b12, b13, pa + c0, pa + c1, pb + c0, pb + c1);
    LGKM_WAIT6(6, a00, a01, b00, b01, b02, b03);
    __builtin_amdgcn_s_setprio(1);
    acc[0][0] = MFMA32(a00, b00, acc[0][0]); acc[0][1] = MFMA32(a00, b01, acc[0][1]); acc[0][2] = MFMA32(a00, b02, acc[0][2]); acc[0][3] = MFMA32(a00, b03, acc[0][3]);
    acc[1][0] = MFMA32(a01, b00, acc[1][0]); acc[1][1] = MFMA32(a01, b01, acc[1][1]); acc[1][2] = MFMA32(a01, b02, acc[1][2]); acc[1][3] = MFMA32(a01, b03, acc[1][3]);
    __builtin_amdgcn_sched_barrier(0);
    LGKM_WAIT6(0, a10, a11, b10, b11, b12, b13);
    acc[0][0] = MFMA32(a10, b10, acc[0][0]); acc[0][1] = MFMA32(a10, b11, acc[0][1]); acc[0][2] = MFMA32(a10, b12, acc[0][2]); acc[0][3] = MFMA32(a10, b13, acc[0][3]);
    acc[1][0] = MFMA32(a11, b10, acc[1][0]); acc[1][1] = MFMA32(a11, b11, acc[1][1]); acc[1][2] = MFMA32(a11, b12, acc[1][2]); acc[1][3] = MFMA32(a11, b13, acc[1][3]);
    __builtin_amdgcn_s_setprio(0);
    __builtin_amdgcn_sched_barrier(0);
    WAIT_V0(); __syncthreads();
  }
}

DI void decode_tile(int idx, int xcd, int nmt, int NT, int& mt_lin, int& nt) {
  const int MB = nmt >> 3;
  if (idx < 8 * NT) { nt = idx >> 3; mt_lin = xcd * MB + (idx & 7); }
  else { const int i2 = idx - 8 * NT, gsz = MB - 8; nt = i2 / gsz; mt_lin = xcd * MB + 8 + i2 % gsz; }
}
DI int map_mtile(int mt, bool latent_only) { return latent_only ? (mt >> 5) * 34 + (mt & 31) : mt; }

DI void store_hm(bf16_t* base, int nh, int hd, int b, int t0, int cs, int h, const f32x16& a) {
  const int hh = cs / hd, d = cs % hd;
  bf16_t* dst = base + ((size_t)(b * nh + hh) * TT + t0) * hd + d;
#pragma unroll
  for (int r = 0; r < 16; ++r) dst[(size_t)crow(r, h) * hd] = f2bf(a[r]);
}
DI void store_tr(bf16_t* base, int nh, int b, int t0, int cs, int h, const f32x16& a) {
  const int hh = cs >> 6, d = cs & 63;
  bf16_t* dst = base + ((size_t)(b * nh + hh) * 64 + d) * TT + t0 + 4 * h;
#pragma unroll
  for (int g = 0; g < 4; ++g) { uint2 o; o.x = pack2(a[4 * g], a[4 * g + 1]); o.y = pack2(a[4 * g + 2], a[4 * g + 3]); *(uint2*)(dst + 8 * g) = o; }
}

DI void phase_gemm1(const Params& p, int bid, int nb, char* smem) {
  bf16_t* sA = (bf16_t*)smem; bf16_t* sB = sA + 2 * WA_STG;
  const bf16_t* H = ws_b(p, OFF_H);
  bf16_t* R = ws_b(p, OFF_S1);
  for (int idx = bid >> 3; idx < 17 * 11; idx += nb >> 3) {
    int mt, nt; decode_tile(idx, bid & 7, 136, 11, mt, nt);
    f32x16 acc[2][4];
#pragma unroll
    for (int a = 0; a < 2; ++a)
#pragma unroll
      for (int c = 0; c < 4; ++c)
#pragma unroll
        for (int r = 0; r < 16; ++r) acc[a][c][r] = 0.f;
    gemm_accum_wide(acc, H + (size_t)mt * 128 * D, D, wb(p, W_IN) + (size_t)nt * 256 * 1024, 1024, 32, sA, sB);
    const int t2 = opaque(threadIdx.x), wm = t2 >> 7, wn = (t2 >> 6) & 1, hq = (t2 >> 5) & 1, lq = t2 & 31;
#pragma unroll
    for (int mi = 0; mi < 2; ++mi)
#pragma unroll
      for (int ni = 0; ni < 4; ++ni) {
        const int row0 = mt * 128 + wm * 64 + mi * 32, c0 = nt * 256 + wn * 128 + ni * 32;
        if (c0 >= NPROJ) continue;
        const int b = row0 / TT, t0 = row0 % TT, col = c0 + lq;
        const f32x16& a = acc[mi][ni];
        if (c0 < RW) {
          bf16_t* dst = R + (size_t)row0 * RW + col;
#pragma unroll
          for (int r = 0; r < 16; ++r) dst[(size_t)crow(r, hq) * RW] = f2bf(a[r]);
        } else {
          const int cc = col - RW, seg = (c0 - RW) >> 8, cs = cc & 255;
          if (seg == 0) store_hm(qkv(p, Q_B), 4, 64, b, t0, cs, hq, a);
          else if (seg == 1) store_hm(qkv(p, K_B), 4, 64, b, t0, cs, hq, a);
          else if (seg == 2) store_tr(qkv(p, V_B), 4, b, t0, cs, hq, a);
          else if (seg == 3) store_hm(qkv(p, Q_C), 8, 32, b, t0, cs, hq, a);
          else if (seg == 4) store_hm(qkv(p, K_C), 8, 32, b, t0, cs, hq, a);
          else if (seg == 5) store_tr(qkv(p, V_C), 4, b, t0, cs, hq, a);
          else if (seg == 6) store_hm(qkv(p, Q_D), 4, 64, b, t0, cs, hq, a);
          else { if (cs < 128) store_hm(qkv(p, K_D), 2, 64, b, t0, cs, hq, a); else store_tr(qkv(p, V_D), 2, b, t0, cs - 128, hq, a); }
        }
      }
  }
}

DI void phase_rowwise(const Params& p, int l, int bid, int nb) {
  const int lane = threadIdx.x & 63, wave = threadIdx.x >> 6;
  bf16_t* R = ws_b(p, OFF_S1);
  float gq[6], gkv[4];
#pragma unroll
  for (int i = 0; i < 6; ++i) gq[i] = p.g_q_a[l * 384 + lane + 64 * i];
#pragma unroll
  for (int i = 0; i < 4; ++i) gkv[i] = p.g_kv_a[l * 256 + lane + 64 * i];
  for (int row = bid * 4 + wave; row < MROWS; row += nb * 4) {
    bf16_t* rr = R + (size_t)row * RW;
    bf16_t lcq[6], lckv[4];
#pragma unroll
    for (int i = 0; i < 6; ++i) lcq[i] = rr[lane + 64 * i];
#pragma unroll
    for (int i = 0; i < 4; ++i) lckv[i] = rr[384 + lane + 64 * i];
    {
      float x[6], ss = 0.f;
#pragma unroll
      for (int i = 0; i < 6; ++i) { x[i] = bf2f(lcq[i]); ss += x[i] * x[i]; }
      ss = wave_sum(ss);
      const float sc = rsqrtf(ss * (1.f / 384.f) + EPS);
#pragma unroll
      for (int i = 0; i < 6; ++i) rr[lane + 64 * i] = f2bf(x[i] * sc * gq[i]);
    }
    {
      float x[4], ss = 0.f;
#pragma unroll
      for (int i = 0; i < 4; ++i) { x[i] = bf2f(lckv[i]); ss += x[i] * x[i]; }
      ss = wave_sum(ss);
      const float sc = rsqrtf(ss * (1.f / 256.f) + EPS);
#pragma unroll
      for (int i = 0; i < 4; ++i) rr[384 + lane + 64 * i] = f2bf(x[i] * sc * gkv[i]);
    }
  }
}
DI void phase_rowwise_b(const Params& p, int l, int bid, int nb) {
  const int lane = threadIdx.x & 63, wave = threadIdx.x >> 6;
  const bf16_t* R = ws_b(p, OFF_S1);
  const float2* t32 = (const float2*)(p.ws + OFF_T32);
  const float2* t64 = (const float2*)(p.ws + OFF_T64);
  const int e = lane & 31;
  const int ax32 = e >> 4, hf32 = (e >> 3) & 1, f32i = e & 7;
  const int ax = lane >> 5, hf = (lane >> 4) & 1, f = lane & 15;
  const float gqn = p.g_qn[l * 64 + lane], gkn = p.g_kn[l * 64 + lane];
  for (int row = bid * 4 + wave; row < MROWS; row += nb * 4) {
    const int b = row / TT, t = row % TT;
    const bool latent = t < SEQ;
    const int pr = (t >> 6) & 63, pc = t & 63;
    bf16_t lq[4], lk[4], lg[6];
    const bf16_t lkpe = R[(size_t)row * RW + 640 + e];
    bf16_t* qptr[4]; bf16_t* kptr[4]; bf16_t* gptr[6];
#pragma unroll
    for (int it = 0; it < 4; ++it) {
      const int m = it * 2 + (lane >> 5);
      qptr[it] = qkv(p, Q_C) + ((size_t)(b * 8 + m) * TT + t) * 32 + e;
      kptr[it] = qkv(p, K_C) + ((size_t)(b * 8 + m) * TT + t) * 32 + e;
      lq[it] = latent ? *qptr[it] : (bf16_t)0; lk[it] = latent ? *kptr[it] : (bf16_t)0;
    }
#pragma unroll
    for (int hh = 0; hh < 6; ++hh) {
      gptr[hh] = (hh < 4) ? qkv(p, Q_D) + ((size_t)(b * 4 + hh) * TT + t) * 64 + lane
                          : qkv(p, K_D) + ((size_t)(b * 2 + (hh - 4)) * TT + t) * 64 + lane;
      lg[hh] = *gptr[hh];
    }
    const float2 cs32 = t32[(ax32 ? pc : pr) * 8 + f32i];
    const float2 cs = t64[(ax ? pc : pr) * 16 + f];
    {
      float x = bf2f(lkpe);
      const float pt = __shfl_xor(x, 8);
      if (latent) x = hf32 ? (pt * cs32.y + x * cs32.x) : (x * cs32.x - pt * cs32.y);
      if (lane < 32) {
        const bf16_t o = f2bf(x);
#pragma unroll
        for (int hh = 0; hh < 4; ++hh) qkv(p, K_A)[((size_t)(b * 4 + hh) * TT + t) * 96 + 64 + e] = o;
      }
    }
    if (latent) {
#pragma unroll
      for (int it = 0; it < 4; ++it) {
        const float xq = bf2f(lq[it]), xk = bf2f(lk[it]);
        const float pq = __shfl_xor(xq, 8), pk = __shfl_xor(xk, 8);
        *qptr[it] = f2bf(hf32 ? (pq * cs32.y + xq * cs32.x) : (xq * cs32.x - pq * cs32.y));
        *kptr[it] = f2bf(hf32 ? (pk * cs32.y + xk * cs32.x) : (xk * cs32.x - pk * cs32.y));
      }
    }
    {
#pragma unroll
      for (int hh = 0; hh < 6; ++hh) {
        const float g = (hh < 4) ? gqn : gkn;
        float x = bf2f(lg[hh]);
        const float ss = wave_sum(x * x);
        x = x * rsqrtf(ss * (1.f / 64.f) + EPS) * g;
        const float pt = __shfl_xor(x, 16);
        if (latent) x = hf ? (pt * cs.y + x * cs.x) : (x * cs.x - pt * cs.y);
        *gptr[hh] = f2bf(x);
      }
    }
  }
}

DI void phase_gemm2(const Params& p, int bid, int nb, char* smem) {
  bf16_t* sA = (bf16_t*)smem; bf16_t* sB = sA + 2 * LTILE;
  const int lane = threadIdx.x & 63, wave = threadIdx.x >> 6, wm = wave >> 1, wn = wave & 1, h = lane >> 5;
  const bf16_t* R = ws_b(p, OFF_S1);
  const float2* t32 = (const float2*)(p.ws + OFF_T32);
  for (int idx = bid >> 3; idx < 17 * 7; idx += nb >> 3) {
    int mt, nt; decode_tile(idx, bid & 7, 136, 7, mt, nt);
    f32x16 acc[2][2]; zero_acc(acc);
    if (nt < 3) gemm_accum(acc, R + (size_t)mt * 128 * RW, RW, wb(p, W_QUP) + (size_t)nt * 128 * 384, 384, 6, sA, sB);
    else gemm_accum(acc, R + (size_t)mt * 128 * RW + 384, RW, wb(p, W_KVUP) + (size_t)(nt - 3) * 128 * 256, 256, 4, sA, sB);
    const int hq = opaque(h), lq = opaque(lane & 31);
#pragma unroll
    for (int mi = 0; mi < 2; ++mi)
#pragma unroll
      for (int ni = 0; ni < 2; ++ni) {
        const int row0 = mt * 128 + wm * 64 + mi * 32;
        const int b = row0 / TT, t0 = row0 % TT;
        const f32x16& a = acc[mi][ni];
        if (nt < 3) {
          const int c0 = nt * 128 + wn * 64 + ni * 32;
          const int hh = c0 / 96, d0 = c0 % 96, e = lq;
          bf16_t* dst = qkv(p, Q_A) + ((size_t)(b * 4 + hh) * TT + t0) * 96 + d0 + e;
          if (d0 == 64 && t0 < SEQ) {
            const int ax = e >> 4, hf = (e >> 3) & 1, f = e & 7;
#pragma unroll
            for (int r = 0; r < 16; ++r) {
              const int t = t0 + crow(r, hq);
              const int pos = ax ? (t & 63) : (t >> 6);
              const float2 cs = t32[pos * 8 + f];
              const float x = a[r], pt = __shfl_xor(x, 8);
              dst[(size_t)crow(r, hq) * 96] = f2bf(hf ? (pt * cs.y + x * cs.x) : (x * cs.x - pt * cs.y));
            }
          } else {
#pragma unroll
            for (int r = 0; r < 16; ++r) dst[(size_t)crow(r, hq) * 96] = f2bf(a[r]);
          }
        } else {
          const int c0 = (nt - 3) * 128 + wn * 64 + ni * 32;
          const int hh = c0 >> 7, d0 = c0 & 127, e = lq;
          if (d0 < 64) {
            bf16_t* dst = qkv(p, K_A) + ((size_t)(b * 4 + hh) * TT + t0) * 96 + d0 + e;
#pragma unroll
            for (int r = 0; r < 16; ++r) dst[(size_t)crow(r, hq) * 96] = f2bf(a[r]);
          } else {
            store_tr(qkv(p, V_A), 4, b, t0, hh * 64 + (d0 - 64) + e, hq, a);
          }
        }
      }
  }
}

DI float dot8(const float* qv, uint4 kv) {
  return qv[0] * __uint_as_float(kv.x << 16) + qv[1] * __uint_as_float(kv.x & 0xffff0000u)
       + qv[2] * __uint_as_float(kv.y << 16) + qv[3] * __uint_as_float(kv.y & 0xffff0000u)
       + qv[4] * __uint_as_float(kv.z << 16) + qv[5] * __uint_as_float(kv.z & 0xffff0000u)
       + qv[6] * __uint_as_float(kv.w << 16) + qv[7] * __uint_as_float(kv.w & 0xffff0000u);
}
DI void online_key(float s, const bf16_t* vcol, float& m, float& lsum, float (&o)[16]) {
  if (s > m) {
    const float c = __expf(m - s);
    lsum *= c;
#pragma unroll
    for (int d = 0; d < 16; ++d) o[d] *= c;
    m = s;
  }
  const float pr = __expf(s - m);
  lsum += pr;
#pragma unroll
  for (int d = 0; d < 16; ++d) o[d] += pr * bf2f(vcol[(size_t)d * TT]);
}
template <int DQK>
DI void naive_dense(const bf16_t* q, const bf16_t* K, const bf16_t* Vt, int k0, int k1, float scale, float (&o)[16]) {
  float qv[DQK];
#pragma unroll
  for (int d = 0; d < DQK; ++d) qv[d] = bf2f(q[d]) * scale;
  float m = -1e30f, lsum = 0.f;
#pragma unroll
  for (int d = 0; d < 16; ++d) o[d] = 0.f;
  for (int key = k0; key < k1; ++key) {
    const bf16_t* kr = K + (size_t)key * DQK;
    float s = 0.f;
#pragma unroll
    for (int d8 = 0; d8 < DQK / 8; ++d8) s += dot8(qv + d8 * 8, *(const uint4*)(kr + d8 * 8));
    online_key(s, Vt + key, m, lsum, o);
  }
  const float inv = 1.f / lsum;
#pragma unroll
  for (int d = 0; d < 16; ++d) o[d] *= inv;
}
DI void store_y(bf16_t* y, const float (&o)[16]) {
#pragma unroll
  for (int d8 = 0; d8 < 2; ++d8) {
    uint4 v; v.x = pack2(o[d8 * 8], o[d8 * 8 + 1]); v.y = pack2(o[d8 * 8 + 2], o[d8 * 8 + 3]); v.z = pack2(o[d8 * 8 + 4], o[d8 * 8 + 5]); v.w = pack2(o[d8 * 8 + 6], o[d8 * 8 + 7]);
    *(uint4*)(y + d8 * 8) = v;
  }
}

DI void phase_attn_naive(const Params& p, int l, int bid, int nb) {
  const int tid = threadIdx.x;
  bf16_t* Y = ws_b(p, OFF_S0);
  const int nqb = (l == 0) ? 68 : 64;
  const int nitems = 4 * 4 * 4 * nqb;
  for (int it = bid; it < nitems; it += nb) {
    const int var = it / (16 * nqb), rem = it % (16 * nqb), b = rem / (4 * nqb), rem2 = rem % (4 * nqb), hh = rem2 / nqb, qb = rem2 % nqb;
    const int t = qb * 64 + (tid >> 2), dq = tid & 3;
    const bool latent = t < SEQ;
    const int k0 = latent ? 0 : SEQ, k1 = TT;
    bf16_t* y = Y + (size_t)(b * TT + t) * D + var * 256 + hh * 64 + dq * 16;
    float o[16];
    if (var == 0) {
      naive_dense<96>(qkv(p, Q_A) + ((size_t)(b * 4 + hh) * TT + t) * 96, qkv(p, K_A) + (size_t)(b * 4 + hh) * TT * 96,
                      qkv(p, V_A) + ((size_t)(b * 4 + hh) * 64 + dq * 16) * TT, k0, k1, 0.10206207261596577f, o);
    } else if (var == 3) {
      const int hk = hh >> 1;
      naive_dense<64>(qkv(p, Q_D) + ((size_t)(b * 4 + hh) * TT + t) * 64, qkv(p, K_D) + (size_t)(b * 2 + hk) * TT * 64,
                      qkv(p, V_D) + ((size_t)(b * 2 + hk) * 64 + dq * 16) * TT, k0, k1, 0.125f, o);
    } else if (var == 2) {
      float o2[16];
      const bf16_t* Vt = qkv(p, V_C) + ((size_t)(b * 4 + hh) * 64 + dq * 16) * TT;
      naive_dense<32>(qkv(p, Q_C) + ((size_t)(b * 8 + hh * 2) * TT + t) * 32, qkv(p, K_C) + (size_t)(b * 8 + hh * 2) * TT * 32, Vt, k0, k1, 0.17677669529663687f, o);
      naive_dense<32>(qkv(p, Q_C) + ((size_t)(b * 8 + hh * 2 + 1) * TT + t) * 32, qkv(p, K_C) + (size_t)(b * 8 + hh * 2 + 1) * TT * 32, Vt, k0, k1, 0.17677669529663687f, o2);
      const float lam = ws_f(p, OFF_LAM)[l * 4 + hh];
      float ss = 0.f;
#pragma unroll
      for (int d = 0; d < 16; ++d) { o[d] -= lam * o2[d]; ss += o[d] * o[d]; }
      ss += __shfl_xor(ss, 1); ss += __shfl_xor(ss, 2);
      const float sc = rsqrtf(ss * (1.f / 64.f) + EPS) * (1.f - lam_init_of(l));
#pragma unroll
      for (int d = 0; d < 16; ++d) o[d] *= sc * p.g_sub[l * 64 + dq * 16 + d];
    } else {
      const bf16_t* Kb = qkv(p, K_B) + (size_t)(b * 4 + hh) * TT * 64;
      const bf16_t* Vt = qkv(p, V_B) + ((size_t)(b * 4 + hh) * 64 + dq * 16) * TT;
      const bf16_t* q = qkv(p, Q_B) + ((size_t)(b * 4 + hh) * TT + t) * 64;
      if (!latent) {
        naive_dense<64>(q, Kb, Vt, SEQ, TT, 0.125f, o);
      } else {
        float qv[64];
#pragma unroll
        for (int d = 0; d < 64; ++d) qv[d] = bf2f(q[d]) * 0.125f;
        float m = -1e30f, lsum = 0.f;
#pragma unroll
        for (int d = 0; d < 16; ++d) o[d] = 0.f;
        const int r = t >> 6, w = t & 63;
        const int rs = min(max(r - 4, 0), 56), cs = min(max(w - 8, 0), 48);
        const float* rpb = p.rpb + (size_t)(l * 4 + hh) * 15 * 31;
        for (int kk = 0; kk < 384; ++kk) {
          int key; float bias = 0.f;
          if (kk < 128) { const int i = kk >> 4, j = kk & 15; key = (rs + i) * 64 + cs + j; bias = rpb[(rs + i - r + 7) * 31 + (cs + j - w + 15)]; }
          else key = SEQ + (kk - 128);
          const bf16_t* kr = Kb + (size_t)key * 64;
          float s = 0.f;
#pragma unroll
          for (int d8 = 0; d8 < 8; ++d8) s += dot8(qv + d8 * 8, *(const uint4*)(kr + d8 * 8));
          online_key(s + bias, Vt + key, m, lsum, o);
        }
        const float inv = 1.f / lsum;
#pragma unroll
        for (int d = 0; d < 16; ++d) o[d] *= inv;
      }
    }
    store_y(y, o);
  }
}

struct TileMap { int nfirst, first0, second0, ntiles; };
constexpr int ATT_SV_OFF = 26624, ATT_BIAS_OFF = 44032;

template <int DQK, bool NA>
DI void flash_pass(const bf16_t* __restrict__ Qg, const bf16_t* __restrict__ Kg, const bf16_t* __restrict__ Vg,
                   int q0, TileMap tm, float c, f32x16 (&o)[2], char* smem, const float* sBias) {
  constexpr int KR = DQK + 8, KT = 64 * KR, VR = 68, VT = 64 * VR, NKC = DQK / 32, CPR = DQK / 8;
  bf16_t* sK = (bf16_t*)smem;
  bf16_t* sV = (bf16_t*)(smem + ATT_SV_OFF);
  const int tid = opaque(threadIdx.x), lane = tid & 63, wave = tid >> 6, h = lane >> 5, li = lane & 31;
  bf16x8 qf[DQK / 16];
  {
    const bf16_t* qp = Qg + (size_t)(q0 + wave * 32 + li) * DQK + h * 8;
#pragma unroll
    for (int kk = 0; kk < DQK / 16; ++kk) qf[kk] = *(const bf16x8*)(qp + kk * 16);
  }
#pragma unroll
  for (int mb = 0; mb < 2; ++mb)
#pragma unroll
    for (int r = 0; r < 16; ++r) o[mb][r] = 0.f;
  float m = -1e30f, lsum = 0.f;
  const int r_w = (q0 >> 6) + (wave >> 1), rs_w = min(max(r_w - 4, 0), 56);
  const int w_q = (wave & 1) * 32 + li, cs_q = min(max(w_q - 8, 0), 48);
  uint4 rk0, rk1, rk2, rv0, rv1;
  rk1 = make_uint4(0, 0, 0, 0); rk2 = rk1;
#define KEY0_OF(tile) ((tile) < tm.nfirst ? tm.first0 + (tile) * 64 : tm.second0 + ((tile) - tm.nfirst) * 64)
#define GK(i) *(const uint4*)(Kg + (size_t)key0 * DQK + (tid + 256 * (i)) * 8)
#define GV(i) *(const uint4*)(Vg + (size_t)((tid + 256 * (i)) >> 3) * TT + key0 + ((tid + 256 * (i)) & 7) * 8)
#define GLOAD(tile) { const int key0 = KEY0_OF(tile); rk0 = GK(0); if (NKC > 1) rk1 = GK(1); if (NKC > 2) rk2 = GK(2); rv0 = GV(0); rv1 = GV(1); }
#define WK(buf, i, r) { const int id = tid + 256 * (i); const int row = id / CPR, cc = id % CPR; *(uint4*)(sK + (buf) * KT + row * KR + cc * 8) = r; }
#define WV(buf, i, r) { const int id = tid + 256 * (i); bf16_t* d = sV + (buf) * VT + (id >> 3) * VR + (id & 7) * 8; \
      *(uint2*)d = make_uint2(r.x, r.y); *(uint2*)(d + 4) = make_uint2(r.z, r.w); }
#define LWRITE(buf) { WK(buf, 0, rk0) if (NKC > 1) WK(buf, 1, rk1) if (NKC > 2) WK(buf, 2, rk2) WV(buf, 0, rv0) WV(buf, 1, rv1) }
  GLOAD(0)
  LWRITE(0)
#pragma unroll
  for (int kk = 0; kk < DQK / 16; ++kk) asm volatile("" :: "v"(qf[kk]));
  __syncthreads();
#pragma unroll 1
  for (int tile = 0; tile < tm.ntiles; ++tile) {
    const int cur = tile & 1;
    const bool more = tile + 1 < tm.ntiles;
    if (more) GLOAD(tile + 1)
    bool active = true;
    int kr = 0;
    if (NA && tile >= tm.nfirst) { kr = (tm.second0 >> 6) + (tile - tm.nfirst); active = (kr >= rs_w) && (kr < rs_w + 8); }
    if (active) {
      f32x16 s[2];
      bf16x8 kf[2][DQK / 16];
#pragma unroll
      for (int kb = 0; kb < 2; ++kb) {
#pragma unroll
        for (int r = 0; r < 16; ++r) s[kb][r] = 0.f;
        const bf16_t* kp = sK + cur * KT + (kb * 32 + li) * KR + h * 8;
#pragma unroll
        for (int kk = 0; kk < DQK / 16; ++kk) {
          if (NA) s[kb] = MFMA32(*(const bf16x8*)(kp + kk * 16), qf[kk], s[kb]);
          else kf[kb][kk] = *(const bf16x8*)(kp + kk * 16);
        }
      }
      if (!NA) {
        __builtin_amdgcn_sched_barrier(0);
#pragma unroll
        for (int kk = 0; kk < DQK / 16; ++kk) {
          s[0] = MFMA32(kf[0][kk], qf[kk], s[0]);
          s[1] = MFMA32(kf[1][kk], qf[kk], s[1]);
        }
      }
      bf16x8 vf[2][2][2];
      if (!NA) {
#pragma unroll
      for (int kb = 0; kb < 2; ++kb)
#pragma unroll
        for (int s2 = 0; s2 < 2; ++s2)
#pragma unroll
          for (int mb = 0; mb < 2; ++mb) {
            const bf16_t* vp = sV + cur * VT + (mb * 32 + li) * VR + kb * 32 + 16 * s2 + 4 * h;
            const uint2 lo = *(const uint2*)vp, hi = *(const uint2*)(vp + 8);
            uint4 u; u.x = lo.x; u.y = lo.y; u.z = hi.x; u.w = hi.y;
            vf[kb][s2][mb] = __builtin_bit_cast(bf16x8, u);
          }
      __builtin_amdgcn_sched_barrier(0);
      }
      if (NA && tile >= tm.nfirst) {
        const float* brow = sBias + (kr - r_w + 7) * 31;
#pragma unroll
        for (int kb = 0; kb < 2; ++kb)
#pragma unroll
          for (int r = 0; r < 16; ++r) {
            const int cidx = kb * 32 + crow(r, h);
            const bool ok = (unsigned)(cidx - cs_q) < 16u;
            const int bi = min(max(cidx - w_q + 15, 0), 30);
            s[kb][r] = ok ? s[kb][r] + 8.f * brow[bi] : -1e30f;
          }
      }
      float mx = s[0][0];
#pragma unroll
      for (int kb = 0; kb < 2; ++kb)
#pragma unroll
        for (int r = 0; r < 16; ++r) mx = fmaxf(mx, s[kb][r]);
      mx = xhalf_max(mx);
      const float m_new = fmaxf(m, mx);
      if (__any(m_new > m)) {
        const float alpha = __builtin_amdgcn_exp2f((m - m_new) * c);
        lsum *= alpha;
#pragma unroll
        for (int mb = 0; mb < 2; ++mb)
#pragma unroll
          for (int r = 0; r < 16; ++r) o[mb][r] *= alpha;
        m = m_new;
      }
      const float mc = m * c;
      bf16x8 pf[2][2];
#pragma unroll
      for (int kb = 0; kb < 2; ++kb) {
        float pv[16];
#pragma unroll
        for (int r = 0; r < 16; ++r) { pv[r] = __builtin_amdgcn_exp2f(fmaf(s[kb][r], c, -mc)); lsum += pv[r]; }
#pragma unroll
        for (int s2 = 0; s2 < 2; ++s2) {
          uint4 u;
          u.x = pack2(pv[8 * s2 + 0], pv[8 * s2 + 1]); u.y = pack2(pv[8 * s2 + 2], pv[8 * s2 + 3]);
          u.z = pack2(pv[8 * s2 + 4], pv[8 * s2 + 5]); u.w = pack2(pv[8 * s2 + 6], pv[8 * s2 + 7]);
          pf[kb][s2] = __builtin_bit_cast(bf16x8, u);
        }
      }
#pragma unroll
      for (int kb = 0; kb < 2; ++kb)
#pragma unroll
        for (int s2 = 0; s2 < 2; ++s2)
#pragma unroll
          for (int mb = 0; mb < 2; ++mb) {
            if (NA) {
              const bf16_t* vp = sV + cur * VT + (mb * 32 + li) * VR + kb * 32 + 16 * s2 + 4 * h;
              const uint2 lo = *(const uint2*)vp, hi = *(const uint2*)(vp + 8);
              uint4 u; u.x = lo.x; u.y = lo.y; u.z = hi.x; u.w = hi.y;
              vf[kb][s2][mb] = __builtin_bit_cast(bf16x8, u);
            }
            o[mb] = MFMA32(vf[kb][s2][mb], pf[kb][s2], o[mb]);
          }
    }
    if (more) LWRITE(cur ^ 1)
    __syncthreads();
  }
  lsum = xhalf_sum(lsum);
  const float inv = 1.f / lsum;
#pragma unroll
  for (int mb = 0; mb < 2; ++mb)
#pragma unroll
    for (int r = 0; r < 16; ++r) o[mb][r] *= inv;
}

DI void store_o(bf16_t* dst  , const f32x16 (&o)[2], int h) {
#pragma unroll
  for (int mb = 0; mb < 2; ++mb)
#pragma unroll
    for (int g = 0; g < 4; ++g) {
      uint2 v; v.x = pack2(o[mb][4 * g], o[mb][4 * g + 1]); v.y = pack2(o[mb][4 * g + 2], o[mb][4 * g + 3]);
      *(uint2*)(dst + mb * 32 + 8 * g + 4 * h) = v;
    }
}

template <int VAR>
DI void attn_items(const Params& p, int l, int bid, int nb, char* smem) {
  const int tid = threadIdx.x, lane = tid & 63, wave = tid >> 6, h = lane >> 5, li = lane & 31;
  float* sBias = (float*)(smem + ATT_BIAS_OFF);
  bf16_t* Y = ws_b(p, OFF_S0);
  const int nitems = (l == 0) ? 512 + 32 : 512;
  constexpr float LOG2E = 1.4426950408889634f;
  for (int it0 = bid >> 3; it0 < nitems / 8; it0 += nb >> 3) {
    const int it = (it0 < 64) ? (bid & 7) * 64 + it0 : 512 + (bid & 7) * 4 + (it0 - 64);
    int b, hh, q0; bool latent;
    if (it < 512) { b = it >> 7; hh = (it >> 5) & 3; q0 = (it & 31) * 128; latent = true; }
    else { const int r = it - 512; b = (r >> 3) & 3; hh = (r >> 1) & 3; q0 = SEQ + (r & 1) * 128; latent = false; }
    TileMap tm;
    if (latent) { tm.nfirst = 68; tm.first0 = 0; tm.second0 = 0; tm.ntiles = 68; }
    else { tm.nfirst = 4; tm.first0 = SEQ; tm.second0 = 0; tm.ntiles = 4; }
    bf16_t* y = Y + (size_t)(b * TT + q0 + wave * 32 + li) * D + VAR * 256 + hh * 64;
    f32x16 o[2];
    if (VAR == 0) {
      flash_pass<96, false>(qkv(p, Q_A) + (size_t)(b * 4 + hh) * TT * 96, qkv(p, K_A) + (size_t)(b * 4 + hh) * TT * 96,
                            qkv(p, V_A) + (size_t)(b * 4 + hh) * 64 * TT, q0, tm, 0.10206207261596577f * LOG2E, o, smem, sBias);
    } else if (VAR == 3) {
      const int hk = hh >> 1;
      flash_pass<64, false>(qkv(p, Q_D) + (size_t)(b * 4 + hh) * TT * 64, qkv(p, K_D) + (size_t)(b * 2 + hk) * TT * 64,
                            qkv(p, V_D) + (size_t)(b * 2 + hk) * 64 * TT, q0, tm, 0.125f * LOG2E, o, smem, sBias);
    } else if (VAR == 2) {
      f32x16 o2[2];
      const bf16_t* Vt = qkv(p, V_C) + (size_t)(b * 4 + hh) * 64 * TT;
      flash_pass<32, false>(qkv(p, Q_C) + (size_t)(b * 8 + hh * 2) * TT * 32, qkv(p, K_C) + (size_t)(b * 8 + hh * 2) * TT * 32, Vt, q0, tm, 0.17677669529663687f * LOG2E, o, smem, sBias);
      flash_pass<32, false>(qkv(p, Q_C) + (size_t)(b * 8 + hh * 2 + 1) * TT * 32, qkv(p, K_C) + (size_t)(b * 8 + hh * 2 + 1) * TT * 32, Vt, q0, tm, 0.17677669529663687f * LOG2E, o2, smem, sBias);
      const float lam = ws_f(p, OFF_LAM)[l * 4 + hh];
      float ss = 0.f;
#pragma unroll
      for (int mb = 0; mb < 2; ++mb)
#pragma unroll
        for (int r = 0; r < 16; ++r) { const float v = o[mb][r] - lam * o2[mb][r]; o[mb][r] = v; ss += v * v; }
      ss = xhalf_sum(ss);
      const float sc = rsqrtf(ss * (1.f / 64.f) + EPS) * (1.f - lam_init_of(l));
#pragma unroll
      for (int mb = 0; mb < 2; ++mb)
#pragma unroll
        for (int r = 0; r < 16; ++r) o[mb][r] *= sc * p.g_sub[l * 64 + mb * 32 + crow(r, h)];
    } else {
      const bf16_t* Qb = qkv(p, Q_B) + (size_t)(b * 4 + hh) * TT * 64;
      const bf16_t* Kb = qkv(p, K_B) + (size_t)(b * 4 + hh) * TT * 64;
      const bf16_t* Vt = qkv(p, V_B) + (size_t)(b * 4 + hh) * 64 * TT;
      if (latent) {
        for (int i = tid; i < 465; i += NTHREADS) sBias[i] = p.rpb[(size_t)(l * 4 + hh) * 465 + i];
        const int r0 = q0 >> 6;
        const int rs0 = min(max(r0 - 4, 0), 56), rs1 = min(max(r0 + 1 - 4, 0), 56);
        tm.nfirst = 4; tm.first0 = SEQ; tm.second0 = rs0 * 64; tm.ntiles = 4 + (rs1 - rs0) + 8;
        flash_pass<64, true>(Qb, Kb, Vt, q0, tm, 0.125f * LOG2E, o, smem, sBias);
      } else {
        flash_pass<64, false>(Qb, Kb, Vt, q0, tm, 0.125f * LOG2E, o, smem, sBias);
      }
    }
    store_o(y, o, h);
  }
}
DI void phase_attn(const Params& p, int l, int bid, int nb, char* smem) {
  attn_items<2>(p, l, bid, nb, smem);
  attn_items<0>(p, l, bid, nb, smem);
  attn_items<3>(p, l, bid, nb, smem);
  attn_items<1>(p, l, bid, nb, smem);
}

DI void phase_merge(const Params& p, int l, int bid, int nb, char* smem) {
  bf16_t* sA = (bf16_t*)smem; bf16_t* sB = sA + 2 * LTILE;
  const bf16_t* H = ws_b(p, OFF_H);
  const bf16_t* Y = ws_b(p, OFF_S0);
  bf16_t* ACC = ws_b(p, OFF_S1);
  for (int idx = bid >> 3; idx < 16 * 8; idx += nb >> 3) {
    int mtl, nt; decode_tile(idx, bid & 7, 128, 8, mtl, nt);
    const int mt = map_mtile(mtl, true);
    f32x16 acc[2][2]; zero_acc(acc);
#pragma unroll 1
    for (int i = 0; i < 4; ++i) {
      unsigned pp[2][2][8];
      {
        f32x16 ap[2][2]; zero_acc(ap);
        gemm_accum_lite(ap, Y + (size_t)mt * 128 * D + i * 256, D, wb(p, W_BR) + ((size_t)i * 1024 + nt * 128) * 256, 256, 4, sA, sB);
#pragma unroll
        for (int a = 0; a < 2; ++a)
#pragma unroll
          for (int c = 0; c < 2; ++c)
#pragma unroll
            for (int r = 0; r < 8; ++r) pp[a][c][r] = pack2(ap[a][c][2 * r], ap[a][c][2 * r + 1]);
      }
      f32x16 ag[2][2]; zero_acc(ag);
      gemm_accum_lite(ag, H + (size_t)mt * 128 * D, D, wb(p, W_IN) + (size_t)(NPROJ + i * 1024 + nt * 128) * 1024, 1024, 16, sA, sB);
#pragma unroll
      for (int a = 0; a < 2; ++a)
#pragma unroll
        for (int c = 0; c < 2; ++c)
#pragma unroll
          for (int r = 0; r < 8; ++r) {
            acc[a][c][2 * r] += __uint_as_float(pp[a][c][r] << 16) * fast_sigmoid(ag[a][c][2 * r]);
            acc[a][c][2 * r + 1] += __uint_as_float(pp[a][c][r] & 0xffff0000u) * fast_sigmoid(ag[a][c][2 * r + 1]);
          }
    }
    const int t2 = opaque(threadIdx.x), wm = t2 >> 7, wn = (t2 >> 6) & 1, hq = (t2 >> 5) & 1, lq = t2 & 31;
#pragma unroll
    for (int mi = 0; mi < 2; ++mi)
#pragma unroll
      for (int ni = 0; ni < 2; ++ni) {
        bf16_t* dst = ACC + (size_t)(mt * 128 + wm * 64 + mi * 32) * D + nt * 128 + wn * 64 + ni * 32 + lq;
#pragma unroll
        for (int r = 0; r < 16; ++r) dst[(size_t)crow(r, hq) * D] = f2bf(acc[mi][ni][r]);
      }
  }
  if (l == 0) {
    for (int u = (nb - 1 - bid); u < 128; u += nb) {
      const int c = u & 7, nt = u >> 3;
      const int mt = (c >> 1) * 34 + 32 + (c & 1);
      f32x16 acc[2];
#pragma unroll
      for (int a = 0; a < 2; ++a)
#pragma unroll
        for (int r = 0; r < 16; ++r) acc[a][r] = 0.f;
#pragma unroll 1
      for (int i = 0; i < 4; ++i) {
        f32x16 ap[2], ag[2];
#pragma unroll
        for (int a = 0; a < 2; ++a)
#pragma unroll
          for (int r = 0; r < 16; ++r) { ap[a][r] = 0.f; ag[a][r] = 0.f; }
        gemm_accum_n64(ap, Y + (size_t)mt * 128 * D + i * 256, D, wb(p, W_BR) + ((size_t)i * 1024 + nt * 64) * 256, 256, 4, sA, sB);
        gemm_accum_n64(ag, H + (size_t)mt * 128 * D, D, wb(p, W_IN) + (size_t)(NPROJ + i * 1024 + nt * 64) * 1024, 1024, 16, sA, sB);
#pragma unroll
        for (int a = 0; a < 2; ++a)
#pragma unroll
          for (int r = 0; r < 16; ++r) acc[a][r] += ap[a][r] * fast_sigmoid(ag[a][r]);
      }
      const int t2 = opaque(threadIdx.x), wm = t2 >> 7, wn = (t2 >> 6) & 1, hq = (t2 >> 5) & 1, lq = t2 & 31;
#pragma unroll
      for (int mi = 0; mi < 2; ++mi) {
        bf16_t* dst = ACC + (size_t)(mt * 128 + wm * 64 + mi * 32) * D + nt * 64 + wn * 32 + lq;
#pragma unroll
        for (int r = 0; r < 16; ++r) dst[(size_t)crow(r, hq) * D] = f2bf(acc[mi][r]);
      }
    }
  }
}

DI void phase_gemm_plain(const Params& p, int l, int bid, int nb, char* smem, const bf16_t* A, int lda, int nk, const bf16_t* Wt, bf16_t* O) {
  {
    bf16_t* sA = (bf16_t*)smem; bf16_t* sB = sA + 2 * WA_STG;
    for (int idx = bid >> 3; idx < 16 * 4; idx += nb >> 3) {
      int mtl, nt; decode_tile(idx, bid & 7, 128, 4, mtl, nt);
      const int mt = map_mtile(mtl, true);
      f32x16 acc[2][4];
#pragma unroll
      for (int a = 0; a < 2; ++a)
#pragma unroll
        for (int c = 0; c < 4; ++c)
#pragma unroll
          for (int r = 0; r < 16; ++r) acc[a][c][r] = 0.f;
      gemm_accum_wide(acc, A + (size_t)mt * 128 * lda, lda, Wt + (size_t)nt * 256 * lda, lda, nk * 2, sA, sB);
      const int t2 = opaque(threadIdx.x), wm = t2 >> 7, wn = (t2 >> 6) & 1, hq = (t2 >> 5) & 1, lq = t2 & 31;
#pragma unroll
      for (int mi = 0; mi < 2; ++mi)
#pragma unroll
        for (int ni = 0; ni < 4; ++ni) {
          bf16_t* dst = O + (size_t)(mt * 128 + wm * 64 + mi * 32) * D + nt * 256 + wn * 128 + ni * 32 + lq;
#pragma unroll
          for (int r = 0; r < 16; ++r) dst[(size_t)crow(r, hq) * D] = f2bf(acc[mi][ni][r]);
        }
    }
  }
  bf16_t* sA = (bf16_t*)smem; bf16_t* sB = sA + 2 * LTILE;
  const int lane = threadIdx.x & 63, wave = threadIdx.x >> 6, wm = wave >> 1, wn = wave & 1, h = lane >> 5;
  if (l == 0) {
    for (int u = (nb - 1 - bid); u < 128; u += nb) {
      const int c = u & 7, nt64 = u >> 3;
      const int mt = (c >> 1) * 34 + 32 + (c & 1);
      f32x16 acc[2];
#pragma unroll
      for (int a = 0; a < 2; ++a)
#pragma unroll
        for (int r = 0; r < 16; ++r) acc[a][r] = 0.f;
      gemm_accum_n64(acc, A + (size_t)mt * 128 * lda, lda, Wt + (size_t)nt64 * 64 * lda, lda, nk, sA, sB);
      const int hq = opaque(h), lq = opaque(lane & 31);
#pragma unroll
      for (int mi = 0; mi < 2; ++mi) {
        bf16_t* dst = O + (size_t)(mt * 128 + wm * 64 + mi * 32) * D + nt64 * 64 + wn * 32 + lq;
#pragma unroll
        for (int r = 0; r < 16; ++r) dst[(size_t)crow(r, hq) * D] = f2bf(acc[mi][r]);
      }
    }
  }
}

DI void phase_gemm4(const Params& p, int l, int bid, int nb, char* smem) {
  bf16_t* sA = (bf16_t*)smem; bf16_t* sB = sA + 2 * WA_STG;
  const bf16_t* H = ws_b(p, OFF_H);
  bf16_t* ACT = ws_b(p, OFF_X2);
  const bool lat = (l == 1);
  const int nmt = lat ? 128 : 136;
  for (int idx = bid >> 3; idx < (nmt >> 3) * 22; idx += nb >> 3) {
    int mtl, nt; decode_tile(idx, bid & 7, nmt, 22, mtl, nt);
    const int mt = map_mtile(mtl, lat);
    f32x16 acc[2][4];
#pragma unroll
    for (int a = 0; a < 2; ++a)
#pragma unroll
      for (int c = 0; c < 4; ++c)
#pragma unroll
        for (int r = 0; r < 16; ++r) acc[a][c][r] = 0.f;
    gemm_accum_wide(acc, H + (size_t)mt * 128 * D, D, wb(p, W_GU) + (size_t)nt * 256 * 1024, 1024, 32, sA, sB);
    const int t2 = opaque(threadIdx.x), wm = t2 >> 7, wn = (t2 >> 6) & 1, hq = (t2 >> 5) & 1, lq = t2 & 31;
#pragma unroll
    for (int mi = 0; mi < 2; ++mi)
#pragma unroll
      for (int j = 0; j < 2; ++j) {
        bf16_t* dst = ACT + (size_t)(mt * 128 + wm * 64 + mi * 32) * DFF + (nt * 4 + wn * 2 + j) * 32 + lq;
#pragma unroll
        for (int r = 0; r < 16; ++r) {
          const float g = acc[mi][2 * j][r], u = acc[mi][2 * j + 1][r];
          dst[(size_t)crow(r, hq) * DFF] = f2bf(g * fast_sigmoid(g) * u);
        }
      }
  }
}

DI void phase_ln(const Params& p, int l, int bid, int nb, const bf16_t* O, int gate_off, const float* lng, const float* lnb, int hl, int hsh_off, int hsc_off, bool src_is_input) {
  const int lane = threadIdx.x & 63, wave = threadIdx.x >> 6;
  bf16_t* H = ws_b(p, OFF_H);
  const float* mod = ws_f(p, OFF_MOD);
  float4 lg[4], lb[4];
#pragma unroll
  for (int i = 0; i < 4; ++i) { const int c = (i * 64 + lane) * 4; lg[i] = *(const float4*)(lng + c); lb[i] = *(const float4*)(lnb + c); }
  const int stride = nb * 4;
  for (int row0 = bid * 4 + wave; row0 < MROWS; row0 += 2 * stride) {
    int rw[2], bb[2], tt[2]; bool ok[2];
#pragma unroll
    for (int k = 0; k < 2; ++k) {
      rw[k] = row0 + k * stride;
      const int rr = min(rw[k], MROWS - 1);
      bb[k] = rr / TT; tt[k] = rr % TT;
      ok[k] = (rw[k] < MROWS) && !(l == 1 && tt[k] >= SEQ);
    }
    float v[2][16];
    float s[2] = {0.f, 0.f};
#pragma unroll
    for (int k = 0; k < 2; ++k) {
      if (!ok[k]) continue;
      const int j = tt[k] < SEQ ? bb[k] : 4;
      const float* src = xsrc_row(p, src_is_input ? 0 : 1, bb[k], tt[k]);
      const float* mg = mod + (size_t)(l * 5 + j) * 6144 + gate_off;
#pragma unroll
      for (int i = 0; i < 4; ++i) {
        const int c = (i * 64 + lane) * 4;
        const float4 x = *(const float4*)(src + c);
        const float4 g = *(const float4*)(mg + c);
        const uint2 ob = *(const uint2*)(O + (size_t)rw[k] * D + c);
        v[k][i * 4 + 0] = ALPHA * x.x + g.x * __uint_as_float(ob.x << 16);
        v[k][i * 4 + 1] = ALPHA * x.y + g.y * __uint_as_float(ob.x & 0xffff0000u);
        v[k][i * 4 + 2] = ALPHA * x.z + g.z * __uint_as_float(ob.y << 16);
        v[k][i * 4 + 3] = ALPHA * x.w + g.w * __uint_as_float(ob.y & 0xffff0000u);
        s[k] += v[k][i * 4] + v[k][i * 4 + 1] + v[k][i * 4 + 2] + v[k][i * 4 + 3];
      }
    }
    float mu[2], rstd[2];
#pragma unroll
    for (int k = 0; k < 2; ++k) mu[k] = wave_sum(s[k]) * (1.f / 1024.f);
    float q[2] = {0.f, 0.f};
#pragma unroll
    for (int k = 0; k < 2; ++k)
#pragma unroll
      for (int i = 0; i < 16; ++i) { v[k][i] -= mu[k]; q[k] += v[k][i] * v[k][i]; }
#pragma unroll
    for (int k = 0; k < 2; ++k) rstd[k] = rsqrtf(wave_sum(q[k]) * (1.f / 1024.f) + EPS);
#pragma unroll
    for (int k = 0; k < 2; ++k) {
      if (!ok[k]) continue;
      const int j = tt[k] < SEQ ? bb[k] : 4;
      float* dst = xdst_row(p, bb[k], tt[k]);
      const float* mh = (hl >= 0) ? mod + (size_t)(hl * 5 + j) * 6144 : mod;
#pragma unroll
      for (int i = 0; i < 4; ++i) {
        const int c = (i * 64 + lane) * 4;
        float4 y;
        y.x = v[k][i * 4 + 0] * rstd[k] * lg[i].x + lb[i].x; y.y = v[k][i * 4 + 1] * rstd[k] * lg[i].y + lb[i].y;
        y.z = v[k][i * 4 + 2] * rstd[k] * lg[i].z + lb[i].z; y.w = v[k][i * 4 + 3] * rstd[k] * lg[i].w + lb[i].w;
        *(float4*)(dst + c) = y;
        if (hl >= 0) {
          const float4 sh = *(const float4*)(mh + hsh_off + c);
          const float4 sc = *(const float4*)(mh + hsc_off + c);
          store_h4(H + (size_t)rw[k] * D + c, y.x * (1.f + sc.x) + sh.x, y.y * (1.f + sc.y) + sh.y, y.z * (1.f + sc.z) + sh.z, y.w * (1.f + sc.w) + sh.w);
        }
      }
    }
  }
}

#define XB_TMO      128
#define XB_XCNT(j)  (256  + 64 * (j))
#define XB_XSUB(j)  (1280 + 64 * (j))
#define XB_XGEN(j)  (2304 + 64 * (j))
#define XB_TOP      3328
#define XB_TOPGEN   3392
#define XCD_BAR_WORDS 3456
#define XB_SPIN_CAP (1u << 18)
#define LAS __attribute__((address_space(3)))
DI unsigned xb_ld(unsigned* p)              { return __hip_atomic_load(p, __ATOMIC_RELAXED, __HIP_MEMORY_SCOPE_AGENT); }
DI unsigned xb_add(unsigned* p, unsigned v) { return __hip_atomic_fetch_add(p, v, __ATOMIC_RELAXED, __HIP_MEMORY_SCOPE_AGENT); }
DI unsigned xb_xcc_id() { return (unsigned)__builtin_amdgcn_s_getreg((3 << 11) | 20) & 0xFu; }
#define XB_SPIN(cond, bar) do { unsigned _sp = 0; while (cond) { __builtin_amdgcn_s_sleep(1); \
    if ((++_sp & 255u) == 0u) { if (xb_ld(&(bar)[XB_TMO])) break; if (_sp > XB_SPIN_CAP) { atomicAdd(&(bar)[XB_TMO], 1u); break; } } } } while (0)
struct XcdBarrier { unsigned* bar; unsigned x; volatile LAS unsigned* st; };
DI XcdBarrier xcd_barrier_post(unsigned* bar, volatile LAS unsigned* st) {
  XcdBarrier b; b.bar = bar; b.x = xb_xcc_id(); b.st = st;
  if (threadIdx.x == 0) (void)xb_add(&bar[XB_XCNT(b.x)], 1u);
  return b;
}
DI void xcd_barrier_complete(unsigned* bar, unsigned x, unsigned& nloc, unsigned& nx) {
  const unsigned G = gridDim.x * gridDim.y * gridDim.z;
  unsigned sum, cnt, mine, sp = 0u;
  for (;;) {
    sum = 0u; cnt = 0u; mine = 0u;
#pragma unroll
    for (unsigned j = 0; j < 16; ++j) { const unsigned c = xb_ld(&bar[XB_XCNT(j)]); sum += c; cnt += (c > 0u) ? 1u : 0u; mine = (j == x) ? c : mine; }
    if (sum == G) break;
    __builtin_amdgcn_s_sleep(1);
    if ((++sp & 255u) == 0u) { if (xb_ld(&bar[XB_TMO])) break; if (sp > XB_SPIN_CAP) { atomicAdd(&bar[XB_TMO], 1u); break; } }
  }
  nloc = mine > 0u ? mine : 1u; nx = cnt > 0u ? cnt : 1u;
}
DI void xcd_barrier(const XcdBarrier& b) {
  asm volatile("s_waitcnt vmcnt(0)" ::: "memory");
  __syncthreads();
  if (threadIdx.x == 0) {
    unsigned* bar = b.bar;
    __builtin_amdgcn_s_waitcnt(0);
    unsigned nloc = b.st[0], nx = b.st[1];
    if (nloc == 0u) { xcd_barrier_complete(bar, b.x, nloc, nx); b.st[0] = nloc; b.st[1] = nx; }
    const unsigned old = xb_add(&bar[XB_XSUB(b.x)], 1u);
    const unsigned gen = old / nloc;
    if (old + 1u == (gen + 1u) * nloc) {
      __builtin_amdgcn_fence(__ATOMIC_RELEASE, "agent");
      asm volatile("s_waitcnt vmcnt(0)" ::: "memory");
      const unsigned og = xb_add(&bar[XB_TOP], 1u);
      const unsigned tg = og / nx;
      if (og + 1u == (tg + 1u) * nx) xb_add(&bar[XB_TOPGEN], 1u);
      else XB_SPIN(xb_ld(&bar[XB_TOPGEN]) == tg, bar);
      __builtin_amdgcn_fence(__ATOMIC_ACQUIRE, "agent");
      xb_add(&bar[XB_XGEN(b.x)], 1u);
      asm volatile("s_waitcnt vmcnt(0)" ::: "memory");
    } else {
      XB_SPIN(xb_ld(&bar[XB_XGEN(b.x)]) == gen, bar);
      __builtin_amdgcn_fence(__ATOMIC_ACQUIRE, "agent");
      asm volatile("s_waitcnt vmcnt(0)" ::: "memory");
    }
  }
  __syncthreads();
}

constexpr int NPHASES = 22;
#define PHASE(idx, body) if (ph_begin <= (idx) && (idx) < ph_end) { body; if ((idx) + 1 < ph_end) { if (ph_end > NPHASES) grid.sync(); else xcd_barrier(xb); } }
template <int L>
DI void run_layer(const Params& p, int ph_begin, int ph_end, int bid, int nb, char* smem, cg::grid_group& grid, const XcdBarrier& xb) {
  constexpr int base = 2 + 10 * L;
  PHASE(base + 0, phase_gemm1(p, bid, nb, smem))
  PHASE(base + 1, phase_rowwise(p, L, bid, nb))
  PHASE(base + 2, { phase_gemm2(p, bid, nb, smem); phase_rowwise_b(p, L, bid, nb); })
  #if NAIVE_ATTN
  PHASE(base + 3, phase_attn_naive(p, L, bid, nb))
#else
  PHASE(base + 3, phase_attn(p, L, bid, nb, smem))
#endif
  PHASE(base + 4, phase_merge(p, L, bid, nb, smem))
  PHASE(base + 5, phase_gemm_plain(p, L, bid, nb, smem, ws_b(p, OFF_S1), 1024, 16, wb(p, W_OUT), ws_b(p, OFF_S0)))
  PHASE(base + 6, phase_ln(p, L, bid, nb, ws_b(p, OFF_S0), 2048, p.ln1_g + L * D, p.ln1_b + L * D, L, 3072, 4096, L == 0))
  PHASE(base + 7, phase_gemm4(p, L, bid, nb, smem))
  PHASE(base + 8, phase_gemm_plain(p, L, bid, nb, smem, ws_b(p, OFF_X2), DFF, 44, wb(p, W_DN), ws_b(p, OFF_S1)))
  PHASE(base + 9, { phase_ln(p, L, bid, nb, ws_b(p, OFF_S1), 5120, p.ln2_g + L * D, p.ln2_b + L * D, (L == 0) ? 1 : -1, 0, 1024, false);
                    if (L == 0) convert_weights(p, 1, bid, nb, smem); })
}
__global__ void __launch_bounds__(NTHREADS, 2) mega(Params p, int ph_begin, int ph_end) {
  __shared__ __attribute__((aligned(1024))) char smem[73728];
  cg::grid_group grid = cg::this_grid();
  const int bid = blockIdx.x, nb = gridDim.x;
  __shared__ uint4 xb_words;
  if (threadIdx.x == 0) xb_words = make_uint4(0u, 0u, 0u, 0u);
  __syncthreads();
  const XcdBarrier xb = xcd_barrier_post((unsigned*)(p.ws + OFF_BAR), (volatile LAS unsigned*)&xb_words);
  PHASE(0, phase_prologue(p, bid, nb, smem))
  PHASE(1, phase_modulate0(p, bid, nb))
  run_layer<0>(p, ph_begin, ph_end, bid, nb, smem, grid, xb);
  run_layer<1>(p, ph_begin, ph_end, bid, nb, smem, grid, xb);
}

extern "C" void kernel_launch(void* const* d_in, const int* in_sizes, int n_in, void* d_out, int out_size, void* d_ws, size_t ws_size, hipStream_t stream) {
  Params p{};
  const float** pp = (const float**)&p;
  for (int i = 0; i < 27; ++i) pp[i] = (const float*)d_in[i];
  p.out = (float*)d_out;
  p.ws = (char*)d_ws;
  static int grid_blocks = 0;
  if (!grid_blocks) {
    int dev = 0, cus = 0, per_cu = 0;
    hipGetDevice(&dev);
    hipDeviceGetAttribute(&cus, hipDeviceAttributeMultiprocessorCount, dev);
    hipOccupancyMaxActiveBlocksPerMultiprocessor(&per_cu, mega, NTHREADS, 0);
    if (per_cu < 1) per_cu = 1;
    grid_blocks = cus * per_cu;
  }
  hipMemsetAsync((char*)d_ws + OFF_BAR, 0, (XCD_BAR_WORDS + 128) * 4, stream);
#if COOP
  int b = 0, e = NPHASES;
  void* args[] = {&p, &b, &e};
  hipError_t err = hipLaunchCooperativeKernel((void*)mega, dim3(grid_blocks), dim3(NTHREADS), args, 0, stream);
  if (err != hipSuccess) fprintf(stderr, "cooperative launch failed: %s (grid %d)\n", hipGetErrorString(err), grid_blocks);
#else
  for (int ph = 0; ph < NPHASES; ++ph) mega<<<grid_blocks, NTHREADS, 0, stream>>>(p, ph, ph + 1);
#endif
}
```
